# Optimizing an MI355X kernel written in HIP

```python
import math
import jax, jax.numpy as jnp
from jax import lax
import numpy as np


D_MODEL = 1024
BATCH = 32
SEQ = 2048
DEPTH = 2

CHUNK = 64
Q_BLOCK = 128
HEAD_DIM = 64
HEADS_FOX = 6
HEADS_SB = 5
HEADS_DSA = 5
IDX_HEADS = 8
IDX_DIM = 64
DSA_TOPK_MAX = 256
D_FF = 4 * D_MODEL
PLE_DIM = 256
ROPE_THETA = 10000.0
LN_EPS = 1e-5
N_BRANCH = 3
NEG = -1e30
DEEPNORM_ALPHA = (2 * DEPTH) ** 0.25
DEEPNORM_BETA = (8 * DEPTH) ** -0.25

W_FOX = HEADS_FOX * HEAD_DIM
W_SB = HEADS_SB * HEAD_DIM
W_DSA = HEADS_DSA * HEAD_DIM
IN_SPLITS = (W_FOX, W_FOX, W_FOX, HEADS_FOX,
             W_SB, W_SB, W_SB,
             W_DSA, HEAD_DIM, HEAD_DIM,
             IDX_HEADS * IDX_DIM, IDX_DIM, IDX_HEADS,
             N_BRANCH * D_MODEL)
C_IN = sum(IN_SPLITS)

kernel_name = 'hybrid_fox_stickbreak_dsa_deepnorm_block'


def split_cols(h):
    out = []
    o = 0
    for w in IN_SPLITS:
        out.append(h[..., o:o + w])
        o += w
    return out


def layer_norm(x, g, b):
    xf = x.astype(jnp.float32)
    mu = jnp.mean(xf, axis=-1, keepdims=True)
    var = jnp.mean(jnp.square(xf - mu), axis=-1, keepdims=True)
    y = (xf - mu) * lax.rsqrt(var + LN_EPS) * g.astype(jnp.float32) + b.astype(jnp.float32)
    return y.astype(x.dtype)


def rope(x, pos):
    half = x.shape[-1] // 2
    inv = ROPE_THETA ** (-jnp.arange(half, dtype=jnp.float32) / half)
    ang = pos.astype(jnp.float32)[:, None] * inv[None, :]
    cos = jnp.cos(ang)[None, :, None, :].astype(x.dtype)
    sin = jnp.sin(ang)[None, :, None, :].astype(x.dtype)
    x1, x2 = x[..., :half], x[..., half:]
    return jnp.concatenate([x1 * cos - x2 * sin, x2 * cos + x1 * sin], axis=-1)


def to_blocks(a):
    b, s = a.shape[:2]
    return jnp.moveaxis(a.reshape(b, s // Q_BLOCK, Q_BLOCK, *a.shape[2:]), 1, 0)


def from_blocks(a):
    nb, b, qb = a.shape[:3]
    return jnp.moveaxis(a, 0, 1).reshape(b, nb * qb, *a.shape[3:])


def fox_attention(q, k, v, log_f):
    b, s, h, dh = q.shape
    c = jnp.cumsum(log_f, axis=1)
    c_k = jnp.transpose(c, (0, 2, 1))[:, :, None, :]
    kpos = jnp.arange(s)
    scale = dh ** -0.5

    def block(args):
        qb, cb, bi = args
        qpos = bi * Q_BLOCK + jnp.arange(Q_BLOCK)
        logits = jnp.einsum('bqhd,bkhd->bhqk', qb, k).astype(jnp.float32) * scale
        logits = logits + jnp.transpose(cb, (0, 2, 1))[..., None] - c_k
        causal = kpos[None, :] <= qpos[:, None]
        logits = jnp.where(causal, logits, NEG)
        w = jax.nn.softmax(logits, axis=-1)
        return jnp.einsum('bhqk,bkhd->bqhd', w.astype(v.dtype), v)

    out = lax.map(block, (to_blocks(q), to_blocks(c), jnp.arange(s // Q_BLOCK)))
    return from_blocks(out).reshape(b, s, h * dh)


def stick_breaking_attention(q, k, v):
    b, s, h, dh = q.shape
    kpos = jnp.arange(s)
    scale = dh ** -0.5

    def block(args):
        qb, bi = args
        qpos = bi * Q_BLOCK + jnp.arange(Q_BLOCK)
        z = jnp.einsum('bqhd,bkhd->bhqk', qb, k).astype(jnp.float32) * scale
        strict = kpos[None, :] < qpos[:, None]
        log_not = jnp.where(strict, jax.nn.log_sigmoid(-z), 0.0)
        after = lax.cumsum(log_not, axis=3, reverse=True) - log_not
        a = jnp.where(strict, jnp.exp(jax.nn.log_sigmoid(z) + after), 0.0)
        return jnp.einsum('bhqk,bkhd->bqhd', a.astype(v.dtype), v)

    out = lax.map(block, (to_blocks(q), jnp.arange(s // Q_BLOCK)))
    return from_blocks(out).reshape(b, s, h * dh)


def dsa_attention(q, k, v, iq, ik, iw):
    b, s, h, dh = q.shape
    n_sel = min(DSA_TOPK_MAX, s // 4)
    kchunk = jnp.arange(s) // CHUNK
    bidx = jnp.arange(b)[:, None, None]
    scale = dh ** -0.5

    def block(args):
        qb, iqb, iwb, bi = args
        qchunk = (bi * Q_BLOCK + jnp.arange(Q_BLOCK)) // CHUNK
        admiss = kchunk[None, :] <= qchunk[:, None]
        idx_logits = jnp.einsum('bqhd,bkd->bqhk', iqb, ik).astype(jnp.float32)
        score = jnp.einsum('bqh,bqhk->bqk', iwb.astype(jnp.float32), jax.nn.relu(idx_logits))
        score = jnp.where(admiss[None], score, NEG)
        _, sel = lax.top_k(score, n_sel)
        sel_ok = (sel // CHUNK) <= qchunk[None, :, None]
        ks = k[bidx, sel]
        vs = v[bidx, sel]
        logits = jnp.einsum('bqhd,bqnd->bhqn', qb, ks).astype(jnp.float32) * scale
        logits = jnp.where(sel_ok[:, None], logits, NEG)
        w = jax.nn.softmax(logits, axis=-1)
        return jnp.einsum('bhqn,bqnd->bqhd', w.astype(vs.dtype), vs)

    out = lax.map(block, (to_blocks(q), to_blocks(iq), to_blocks(iw), jnp.arange(s // Q_BLOCK)))
    return from_blocks(out).reshape(b, s, h * dh)


def setup_inputs(seed: int = 0) -> dict:
    key = jax.random.key(seed)
    ks = jax.random.split(key, 20)
    n = jax.random.normal
    f32 = jnp.float32
    L = DEPTH
    bt = DEEPNORM_BETA
    return {
        'x': n(ks[0], (BATCH, SEQ, D_MODEL), f32),
        'p': n(ks[1], (DEPTH, BATCH, SEQ, PLE_DIM), f32),
        'w_in': n(ks[2], (L, D_MODEL, C_IN), f32) * D_MODEL ** -0.5,
        'b_forget': 2.0 + 0.5 * n(ks[3], (L, HEADS_FOX), f32),
        'w_up_fox': n(ks[4], (L, W_FOX, D_MODEL), f32) * W_FOX ** -0.5 * bt,
        'w_up_sb': n(ks[5], (L, W_SB, D_MODEL), f32) * W_SB ** -0.5 * bt,
        'w_up_dsa': n(ks[6], (L, W_DSA, D_MODEL), f32) * W_DSA ** -0.5 * bt,
        'w_out': n(ks[7], (L, D_MODEL, D_MODEL), f32) * D_MODEL ** -0.5 * bt,
        'ln1_g': 1.0 + 0.05 * n(ks[8], (L, D_MODEL), f32),
        'ln1_b': 0.02 * n(ks[9], (L, D_MODEL), f32),
        'w_ff_in': n(ks[10], (L, D_MODEL, D_FF), f32) * D_MODEL ** -0.5,
        'w_ff_out': n(ks[11], (L, D_FF, D_MODEL), f32) * D_FF ** -0.5 * bt,
        'w_ple': n(ks[12], (L, PLE_DIM, D_MODEL), f32) * PLE_DIM ** -0.5 * bt,
        'w_ple_gate': n(ks[13], (L, D_MODEL, D_MODEL), f32) * D_MODEL ** -0.5,
        'ln2_g': 1.0 + 0.05 * n(ks[14], (L, D_MODEL), f32),
        'ln2_b': 0.02 * n(ks[15], (L, D_MODEL), f32),
    }


def reference(x, p, w_in, b_forget, w_up_fox, w_up_sb, w_up_dsa, w_out, ln1_g, ln1_b,
              w_ff_in, w_ff_out, w_ple, w_ple_gate, ln2_g, ln2_b):
    b, s, _ = x.shape
    pos = jnp.arange(s)
    for i in range(DEPTH):
        h = x @ w_in[i]
        (fq, fk, fv, ff_logit, sq, sk, sv, dq, dk, dv, iq, ik, iw, g) = split_cols(h)
        fq = fq.reshape(b, s, HEADS_FOX, HEAD_DIM)
        fk = fk.reshape(b, s, HEADS_FOX, HEAD_DIM)
        fv = fv.reshape(b, s, HEADS_FOX, HEAD_DIM)
        log_f = jax.nn.log_sigmoid(ff_logit.astype(jnp.float32) + b_forget[i].astype(jnp.float32))
        o_fox = fox_attention(fq, fk, fv, log_f)

        o_sb = stick_breaking_attention(sq.reshape(b, s, HEADS_SB, HEAD_DIM),
                                        sk.reshape(b, s, HEADS_SB, HEAD_DIM),
                                        sv.reshape(b, s, HEADS_SB, HEAD_DIM))

        dq = rope(dq.reshape(b, s, HEADS_DSA, HEAD_DIM), pos)
        dk = rope(dk[:, :, None, :], pos)[:, :, 0, :]
        iq = rope(iq.reshape(b, s, IDX_HEADS, IDX_DIM), pos)
        ik = rope(ik[:, :, None, :], pos)[:, :, 0, :]
        o_dsa = dsa_attention(dq, dk, dv, iq, ik, iw)

        gates = jax.nn.sigmoid(g.reshape(b, s, N_BRANCH, D_MODEL))
        merged = (gates[:, :, 0] * (o_fox @ w_up_fox[i])
                  + gates[:, :, 1] * (o_sb @ w_up_sb[i])
                  + gates[:, :, 2] * (o_dsa @ w_up_dsa[i]))
        x = layer_norm(DEEPNORM_ALPHA * x + merged @ w_out[i], ln1_g[i], ln1_b[i])

        ffn = jnp.square(jax.nn.relu(x @ w_ff_in[i])) @ w_ff_out[i]
        ple = jax.nn.sigmoid(x @ w_ple_gate[i]) * (p[i] @ w_ple[i])
        x = layer_norm(DEEPNORM_ALPHA * x + ffn + ple, ln2_g[i], ln2_b[i])
    return x
```

```cpp
#include <hip/hip_runtime.h>
#include <hip/hip_cooperative_groups.h>
#include <cstdio>
#include <cstdint>
namespace cg = cooperative_groups;
__device__ __forceinline__ int opaque_tid() { int t = (int)threadIdx.x; asm volatile("" : "+v"(t)); return t; }
namespace pg8 {
#define PG8_LAS __attribute__((address_space(3)))
typedef unsigned short bf16_t;
typedef short bf16x8 __attribute__((ext_vector_type(8)));
typedef float f32x4 __attribute__((ext_vector_type(4)));
typedef unsigned u32x4 __attribute__((ext_vector_type(4)));
constexpr int BM = 256, BK = 64, HALF = 128, HTB = HALF * BK * 2, STAGE_BYTES = 8 * HTB, NXCD = 8, WGM = 4;

__host__ __device__ __forceinline__ int lds_byte(int r, int c) { const int st = (r >> 4) * 2 + (c >> 5), rr = r & 15, cc = c & 31, ob = rr * 64 + cc * 2; return st * 1024 + (ob ^ (((ob >> 9) & 1) << 5)); }
__host__ __device__ __forceinline__ void stage_rc(int b, int& R, int& C) { const int st = b / 1024, sb = b % 1024, swz = sb ^ (((sb >> 9) & 1) << 5); R = (st >> 1) * 16 + swz / 64; C = (st & 1) * 32 + (swz % 64) / 2; }
__host__ __device__ __forceinline__ int perm32(int rho) { const int n = rho >> 4, i = rho & 15; return 8 * (i >> 2) + 4 * n + (i & 3); }

struct Unit { int pm, pn; };
struct Gemm { const bf16_t* A; const bf16_t* Bt; int M, N, K; };

struct StaticOrder {
    int nM, nN, nwg, G, c;
    __host__ __device__ __forceinline__ void init(int M, int N, int G_, int c_) { nM = M / BM; nN = N / BM; nwg = nM * nN; G = G_; c = c_; }
    __host__ __device__ __forceinline__ bool next(int i, Unit& u) const {
        const long L = (long)i * G + c; if (L >= nwg) return false;
        int wgid = (int)L; { const int q = nwg / NXCD, r = nwg % NXCD, xcd = wgid % NXCD, off = wgid / NXCD; wgid = (xcd < r ? xcd * (q + 1) : r * (q + 1) + (xcd - r) * q) + off; }
        const int nig = WGM * nN, gid = wgid / nig, fm = gid * WGM, gsz = (nM - fm) < WGM ? (nM - fm) : WGM;
        u.pm = fm + ((wgid % nig) % gsz); u.pn = (wgid % nig) / gsz; return true;
    }
    __device__ __forceinline__ void a_ready(const Unit&) const {}
    __device__ __forceinline__ void done(const Unit&) const {}
};

template <class Epi, class Sched, bool ALIGN_EPI = false, bool SP2 = false>
__device__ __forceinline__ void gemm_phase(PG8_LAS unsigned char* lds, const Gemm g, const Sched& S, const Epi& E) {
    const int tid = opaque_tid(), wid = __builtin_amdgcn_readfirstlane(tid >> 6), lane = tid & 63, wr = wid >> 2, wc = wid & 3, fr = lane & 15, fq = lane >> 4;
    const int K = g.K, nt = K / BK;
    unsigned voffA[2], voffB[2];
#pragma unroll
    for (int i = 0; i < 2; ++i) { int R, C; stage_rc(tid * 16 + i * 8192, R, C); const int Rb = Epi::PERM ? ((R & ~31) + perm32(R & 31)) : R;
        voffA[i] = (unsigned)(R * K + C) * 2u; voffB[i] = (unsigned)(Rb * K + C) * 2u; }
    const size_t kstep = (size_t)(BK * 2);
    const size_t hstep = (size_t)HALF * K * 2;
    const size_t tstep = 2 * hstep;
    const unsigned ldsw = (unsigned)wid * 1024u;
    const int aoff = lds_byte(wr * 64 + fr, fq * 8), boff = lds_byte(wc * 32 + fr, fq * 8);
#define PG8_SA(b, h) (((b) * 2 + (h)) * HTB)
#define PG8_SB(b, h) ((4 + (b) * 2 + (h)) * HTB)
#define PG8_STAGE(bufoff, gbase, voff) do { _Pragma("unroll") for (int _i = 0; _i < 2; ++_i) \
        __builtin_amdgcn_global_load_lds((const unsigned*)((const char*)(gbase) + (voff)[_i]), (PG8_LAS unsigned*)(lds + (bufoff) + ldsw + _i * 8192), 16, 0, 0); } while (0)
#define PG8_LDA(dst, b, h) do { _Pragma("unroll") for (int m = 0; m < 4; ++m) _Pragma("unroll") for (int k = 0; k < 2; ++k) dst[m][k] = *(const PG8_LAS bf16x8*)(lds + PG8_SA(b, h) + aoff + m * 2048 + k * 1024); } while (0)
#define PG8_LDB(dst, b, h) do { _Pragma("unroll") for (int n = 0; n < 2; ++n) _Pragma("unroll") for (int k = 0; k < 2; ++k) dst[n][k] = *(const PG8_LAS bf16x8*)(lds + PG8_SB(b, h) + boff + n * 2048 + k * 1024); } while (0)
#define PG8_MMA(ai, bj, At, Bt) do { __builtin_amdgcn_s_setprio(1); _Pragma("unroll") for (int m = 0; m < 4; ++m) _Pragma("unroll") for (int n = 0; n < 2; ++n) _Pragma("unroll") for (int k = 0; k < 2; ++k) \
        acc[ai][bj][m][n] = __builtin_amdgcn_mfma_f32_16x16x32_bf16(Bt[n][k], At[m][k], acc[ai][bj][m][n], 0, 0, 0); __builtin_amdgcn_s_setprio(0); } while (0)
#define PG8_WAIT_V(n) asm volatile("s_waitcnt vmcnt(" #n ")" ::: "memory")
#define PG8_WAIT_L(n) asm volatile("s_waitcnt lgkmcnt(" #n ")" ::: "memory")
#define PG8_BAR __builtin_amdgcn_s_barrier()
#define PG8_SCHED __builtin_amdgcn_sched_barrier(0)
    Unit cur, nxt; int ui = 0;
    if (!S.next(0, cur)) return;
    f32x4 acc[2][2][4][2];
#pragma unroll
    for (int a = 0; a < 2; ++a)
#pragma unroll
        for (int b = 0; b < 2; ++b)
#pragma unroll
            for (int m = 0; m < 4; ++m)
#pragma unroll
                for (int n = 0; n < 2; ++n) acc[a][b][m][n] = (f32x4){0.f, 0.f, 0.f, 0.f};
    bf16x8 At[4][2], B0[2][2], B1[2][2];
    const char* cA = (const char*)g.A + (size_t)cur.pm * tstep; const char* cB = (const char*)g.Bt + (size_t)cur.pn * tstep;
    S.a_ready(cur);
    if constexpr (SP2) {
        PG8_STAGE(PG8_SB(0, 0), cB, voffB); PG8_STAGE(PG8_SB(0, 1), cB + hstep, voffB); PG8_STAGE(PG8_SA(0, 0), cA, voffA); PG8_STAGE(PG8_SA(0, 1), cA + hstep, voffA);
        if (wr == 1) PG8_BAR;
        PG8_WAIT_V(2); PG8_BAR;
        PG8_STAGE(PG8_SB(1, 0), cB + kstep, voffB); PG8_STAGE(PG8_SA(1, 0), cA + kstep, voffA); PG8_STAGE(PG8_SB(1, 1), cB + hstep + kstep, voffB);
        PG8_WAIT_V(6); PG8_BAR;
    } else {
        PG8_STAGE(PG8_SB(0, 0), cB, voffB); PG8_STAGE(PG8_SA(0, 0), cA, voffA); PG8_STAGE(PG8_SB(0, 1), cB + hstep, voffB); PG8_STAGE(PG8_SA(0, 1), cA + hstep, voffA);
        if (wr == 1) PG8_BAR;
        PG8_WAIT_V(4); PG8_BAR;
        PG8_STAGE(PG8_SB(1, 0), cB + kstep, voffB); PG8_STAGE(PG8_SA(1, 0), cA + kstep, voffA); PG8_STAGE(PG8_SB(1, 1), cB + hstep + kstep, voffB);
        PG8_WAIT_V(6); PG8_BAR;
    }
    for (;;) {
        const bool has_next = S.next(ui + 1, nxt);
        const char* nA = has_next ? (const char*)g.A + (size_t)nxt.pm * tstep : cA; const char* nB = has_next ? (const char*)g.Bt + (size_t)nxt.pn * tstep : cB;
        constexpr int NSEG = Epi::MIDK > 0 ? 2 : 1;
#pragma unroll
        for (int seg = 0; seg < NSEG; ++seg) {
        const int t0 = (NSEG == 2 && seg == 1) ? Epi::MIDK : 0, t1 = (NSEG == 2 && seg == 0) ? Epi::MIDK : nt;
        if constexpr (Epi::MIDK > 0) { if (seg == 1) E.mid(acc, cur, wr, wc, fr, fq); }
#pragma unroll 1
        for (int t = t0; t < t1; t += 2) {
            const bool last = (t == nt - 2);
            const char* a1 = cA + (size_t)(t + 1) * kstep;
            const char* a2 = last ? nA : cA + (size_t)(t + 2) * kstep; const char* b2 = last ? nB : cB + (size_t)(t + 2) * kstep;
            const char* a3 = a2 + kstep; const char* b3 = b2 + kstep;
            if (last && has_next) S.a_ready(nxt);
            if constexpr (SP2) {
            PG8_LDB(B0, 0, 0); PG8_LDB(B1, 0, 1); PG8_SCHED; PG8_LDA(At, 0, 0); PG8_STAGE(PG8_SA(1, 1), a1 + hstep, voffA);
            PG8_WAIT_V(8); PG8_WAIT_L(0); PG8_BAR; PG8_MMA(0, 0, At, B0); PG8_MMA(0, 1, At, B1); PG8_BAR; PG8_SCHED;
            PG8_LDA(At, 0, 1); PG8_STAGE(PG8_SB(0, 0), b2, voffB); PG8_STAGE(PG8_SB(0, 1), b2 + hstep, voffB); PG8_STAGE(PG8_SA(0, 0), a2, voffA);
            PG8_WAIT_V(8); PG8_WAIT_L(0); PG8_BAR; PG8_MMA(1, 0, At, B0); PG8_MMA(1, 1, At, B1); PG8_BAR; PG8_SCHED;
            PG8_LDB(B0, 1, 0); PG8_LDB(B1, 1, 1); PG8_SCHED; PG8_LDA(At, 1, 0); PG8_STAGE(PG8_SA(0, 1), a2 + hstep, voffA);
            PG8_WAIT_V(8); PG8_WAIT_L(0); PG8_BAR; PG8_MMA(0, 0, At, B0); PG8_MMA(0, 1, At, B1); PG8_BAR; PG8_SCHED;
            PG8_LDA(At, 1, 1); PG8_STAGE(PG8_SB(1, 0), b3, voffB); PG8_STAGE(PG8_SB(1, 1), b3 + hstep, voffB); PG8_STAGE(PG8_SA(1, 0), a3, voffA);
            PG8_WAIT_V(8); PG8_WAIT_L(0); PG8_BAR; PG8_MMA(1, 0, At, B0); PG8_MMA(1, 1, At, B1); PG8_BAR; PG8_SCHED;
            } else {
            PG8_LDB(B0, 0, 0); PG8_SCHED; PG8_LDA(At, 0, 0); PG8_STAGE(PG8_SA(1, 1), a1 + hstep, voffA);
            PG8_WAIT_L(8); PG8_BAR; PG8_WAIT_L(0); PG8_MMA(0, 0, At, B0); PG8_BAR; PG8_SCHED;
            PG8_LDB(B1, 0, 1); PG8_STAGE(PG8_SB(0, 0), b2, voffB);
            PG8_BAR; PG8_WAIT_L(0); PG8_MMA(0, 1, At, B1); PG8_BAR;
            PG8_LDA(At, 0, 1); PG8_STAGE(PG8_SA(0, 0), a2, voffA);
            PG8_BAR; PG8_WAIT_L(0); PG8_MMA(1, 0, At, B0); PG8_BAR; PG8_SCHED;
            PG8_STAGE(PG8_SB(0, 1), b2 + hstep, voffB);
            PG8_WAIT_V(6); PG8_BAR; PG8_MMA(1, 1, At, B1); PG8_BAR;
            PG8_LDB(B0, 1, 0); PG8_SCHED; PG8_LDA(At, 1, 0); PG8_STAGE(PG8_SA(0, 1), a2 + hstep, voffA);
            PG8_WAIT_L(8); PG8_BAR; PG8_WAIT_L(0); PG8_MMA(0, 0, At, B0); PG8_BAR; PG8_SCHED;
            PG8_LDB(B1, 1, 1); PG8_STAGE(PG8_SB(1, 0), b3, voffB);
            PG8_BAR; PG8_WAIT_L(0); PG8_MMA(0, 1, At, B1); PG8_BAR;
            PG8_LDA(At, 1, 1); PG8_STAGE(PG8_SA(1, 0), a3, voffA);
            PG8_BAR; PG8_WAIT_L(0); PG8_MMA(1, 0, At, B0); PG8_BAR; PG8_SCHED;
            PG8_STAGE(PG8_SB(1, 1), b3 + hstep, voffB);
            PG8_WAIT_V(6); PG8_BAR; PG8_MMA(1, 1, At, B1); PG8_BAR;
            }
        }
        }
        if constexpr (ALIGN_EPI) { if (wr == 0) PG8_BAR; }
        if constexpr (Epi::CHAIN) {
            E.chain(acc, cur, has_next, wr, wc, fr, fq); S.done(cur);
            if (!has_next) break;
        } else {
        if constexpr (!Epi::AFTER_DRAIN) { E(acc, cur, wr, wc, fr, fq); S.done(cur); }
        if (!has_next) break;
#pragma unroll
        for (int a = 0; a < 2; ++a)
#pragma unroll
            for (int b = 0; b < 2; ++b)
#pragma unroll
                for (int m = 0; m < 4; ++m)
#pragma unroll
                    for (int n = 0; n < 2; ++n) acc[a][b][m][n] = (f32x4){0.f, 0.f, 0.f, 0.f};
        }
        cur = nxt; cA = nA; cB = nB; ++ui;
        if constexpr (ALIGN_EPI) { if (wr == 1) PG8_BAR; }
    }
    PG8_WAIT_V(0);
    if constexpr (!ALIGN_EPI) { if (wr == 0) PG8_BAR; }
    PG8_BAR;
    if constexpr (Epi::AFTER_DRAIN) { E.fused(acc, cur, wr, wc, fr, fq, lds, wid, lane); S.done(cur); }
#undef PG8_SA
#undef PG8_SB
#undef PG8_STAGE
#undef PG8_LDA
#undef PG8_LDB
#undef PG8_MMA
#undef PG8_WAIT_V
#undef PG8_WAIT_L
#undef PG8_BAR
#undef PG8_SCHED
}
}
using pg8::bf16_t; using pg8::bf16x8; using pg8::f32x4; using pg8::u32x4;
#define LAS __attribute__((address_space(3)))
#define GAS __attribute__((address_space(1)))
typedef float f32x16 __attribute__((ext_vector_type(16)));
typedef short s16x4 __attribute__((ext_vector_type(4)));
typedef float f32x2_t __attribute__((ext_vector_type(2)));
typedef __bf16 bf16x2_t __attribute__((ext_vector_type(2)));
typedef unsigned u32x2 __attribute__((ext_vector_type(2)));
typedef short v4i16_t __attribute__((ext_vector_type(4)));
#define MFMA32(a, b, c) __builtin_amdgcn_mfma_f32_32x32x16_bf16((a), (b), (c), 0, 0, 0)

constexpr int T_TOK = 65536, SEQ = 2048, DM = 1024, LDH = 3136, NIN = 3328, CIN = 6222, DFF = 4096, NFF1 = 5120, OCW = 384, HFP = 256 + DFF;
constexpr float ALPHA = 1.4142135623730951f, L2E = 1.4426950408889634f, LN_EPS = 1e-5f, NEGF = -1e30f;
constexpr size_t MiB = (size_t)1 << 20;
constexpr size_t WS_CTL = 0, WS_TRIG = 1 * MiB, WS_W = 2 * MiB, W_LAYER = 40 * MiB;
constexpr size_t WO_IN = 0, WO_G = 7 * MiB, WO_UP = 13 * MiB, WO_OUT = 16 * MiB, WO_FF1 = 18 * MiB, WO_FF2 = 28 * MiB, WO_PLE = 36 * MiB;
constexpr size_t WS_PB = 82 * MiB, WS_MB = 146 * MiB, WS_FL = 162 * MiB, WS_IW = 164 * MiB, WS_XB = 166 * MiB, WS_OC = 294 * MiB, WS_A = 438 * MiB;
constexpr size_t WS_HA = WS_A, WS_SCR = WS_A + 392 * MiB, WS_HFF = WS_A, WS_MF = WS_A, WS_G = WS_A + 256 * MiB, WS_PG = WS_OC, WS_END = 984 * MiB;
constexpr size_t OC_STRIDE = (size_t)T_TOK * OCW;
constexpr int LDS_SLOT = 131072, LDS_BYTES = 131072 + 256;

__device__ __forceinline__ unsigned cvtpk(float lo, float hi) { f32x2_t v = {lo, hi}; bf16x2_t b = __builtin_convertvector(v, bf16x2_t); return __builtin_bit_cast(unsigned, b); }
__device__ __forceinline__ float bflo(unsigned w) { return __uint_as_float(w << 16); }
__device__ __forceinline__ float bfhi(unsigned w) { return __uint_as_float(w & 0xffff0000u); }
__device__ __forceinline__ u32x4 pack8(f32x4 a, f32x4 b) { u32x4 w; w.x = cvtpk(a[0], a[1]); w.y = cvtpk(a[2], a[3]); w.z = cvtpk(b[0], b[1]); w.w = cvtpk(b[2], b[3]); return w; }
__device__ __forceinline__ float ex2(float x) { return __builtin_amdgcn_exp2f(x); }
__device__ __forceinline__ float sigm(float x) { return __builtin_amdgcn_rcpf(1.f + ex2(-x * L2E)); }
__device__ __forceinline__ void l1_inv() { __builtin_amdgcn_fence(__ATOMIC_ACQUIRE, "agent"); }

struct NoLoad {};
template <class F> struct EpiF {
    static constexpr bool PERM = true, AFTER_DRAIN = false, CHAIN = false; static constexpr int MIDK = 0; F f;
    __device__ __forceinline__ void operator()(const f32x4 (&acc)[2][2][4][2], const pg8::Unit& u, int wr, int wc, int fr, int fq) const {
        const int row0 = u.pm * 256 + wr * 64 + fr, col0 = u.pn * 256 + wc * 32 + 8 * fq;
        f.begin();
        typename F::L cur0 = f.load(row0, col0), cur1 = f.load(row0, col0 + 128);
#pragma unroll
        for (int b = 0; b < 8; ++b) {
            const int row = row0 + (b >> 2) * 128 + (b & 3) * 16;
            typename F::L nxt0 = cur0, nxt1 = cur1;
            if (b + 1 < 8) { const int rn = row0 + ((b + 1) >> 2) * 128 + ((b + 1) & 3) * 16; nxt0 = f.load(rn, col0); nxt1 = f.load(rn, col0 + 128); }
            f.apply(row, col0, acc[b >> 2][0][b & 3][0], acc[b >> 2][0][b & 3][1], cur0);
            f.apply(row, col0 + 128, acc[b >> 2][1][b & 3][0], acc[b >> 2][1][b & 3][1], cur1);
            cur0 = nxt0; cur1 = nxt1;
        }
    }
};
struct FIn {
    struct L { f32x4 t0, t1; };
    GAS bf16_t* HA; GAS float* FL; GAS float* IW; const GAS float* cs;
    __device__ __forceinline__ void begin() const {}
    static __device__ __forceinline__ bool is_rope(int c0) { return (c0 >= 2112 && c0 < 2496) || (c0 >= 2560 && c0 < 3136); }
    __device__ __forceinline__ L load(int row, int c0) const {
        L l; l.t0 = (f32x4){1.f, 0.f, 1.f, 0.f}; l.t1 = l.t0;
        if (is_rope(c0)) { const int pos = row & (SEQ - 1), i0 = (c0 & 63) >> 1; const GAS float* tp = cs + ((size_t)pos * 32 + i0) * 2; l.t0 = *(const GAS f32x4*)tp; l.t1 = *(const GAS f32x4*)(tp + 4); }
        return l;
    }
    __device__ __forceinline__ void apply(int row, int c0, f32x4 v0, f32x4 v1, const L& l) const {
        if (c0 >= 3152) return;
        if (c0 >= 3136) { GAS float* d = (c0 == 3136 ? FL : IW) + (size_t)row * 8; *(GAS f32x4*)d = v0; *(GAS f32x4*)(d + 4) = v1; return; }
        if (is_rope(c0)) {
            const f32x4 t0 = l.t0, t1 = l.t1;
            float a, b;
            a = v0[0] * t0[0] - v0[1] * t0[1]; b = v0[1] * t0[0] + v0[0] * t0[1]; v0[0] = a; v0[1] = b;
            a = v0[2] * t0[2] - v0[3] * t0[3]; b = v0[3] * t0[2] + v0[2] * t0[3]; v0[2] = a; v0[3] = b;
            a = v1[0] * t1[0] - v1[1] * t1[1]; b = v1[1] * t1[0] + v1[0] * t1[1]; v1[0] = a; v1[1] = b;
            a = v1[2] * t1[2] - v1[3] * t1[3]; b = v1[3] * t1[2] + v1[2] * t1[3]; v1[2] = a; v1[3] = b;
        }
        const bool isq = (c0 < 384) || (c0 >= 1152 && c0 < 1472) || (c0 >= 2112 && c0 < 2432);
        if (isq) { v0 = v0 * (0.125f * L2E); v1 = v1 * (0.125f * L2E); }
        *(GAS u32x4*)(HA + (size_t)row * LDH + c0) = pack8(v0, v1);
    }
};
struct FGateT {
    typedef NoLoad L;
    GAS unsigned char* Gt; int ro, co;
    __device__ __forceinline__ void begin() const {}
    __device__ __forceinline__ L load(int, int) const { return L{}; }
    __device__ __forceinline__ void apply(int row, int c0, f32x4 v0, f32x4 v1, const L&) const {
        u32x2 w; w.x = 0u; w.y = 0u;
        w.x = __builtin_amdgcn_cvt_pk_u8_f32(sigm(v0[0]) * 255.f, 0, w.x); w.x = __builtin_amdgcn_cvt_pk_u8_f32(sigm(v0[1]) * 255.f, 1, w.x);
        w.x = __builtin_amdgcn_cvt_pk_u8_f32(sigm(v0[2]) * 255.f, 2, w.x); w.x = __builtin_amdgcn_cvt_pk_u8_f32(sigm(v0[3]) * 255.f, 3, w.x);
        w.y = __builtin_amdgcn_cvt_pk_u8_f32(sigm(v1[0]) * 255.f, 0, w.y); w.y = __builtin_amdgcn_cvt_pk_u8_f32(sigm(v1[1]) * 255.f, 1, w.y);
        w.y = __builtin_amdgcn_cvt_pk_u8_f32(sigm(v1[2]) * 255.f, 2, w.y); w.y = __builtin_amdgcn_cvt_pk_u8_f32(sigm(v1[3]) * 255.f, 3, w.y);
        *(GAS u32x2*)(Gt + (row - ro) * 256 + (c0 - co)) = w;
    }
};
struct FUpT {
    struct L { u32x2 g; u32x4 m; };
    const GAS unsigned char* Gt; GAS bf16_t* Mt; GAS bf16_t* MG; int ro, co, mode;
    __device__ __forceinline__ void begin() const { l1_inv(); }
    __device__ __forceinline__ L load(int row, int c0) const {
        const int o = (row - ro) * 256 + (c0 - co);
        L l; l.g = *(const GAS u32x2*)(Gt + o); l.m = (u32x4){0u, 0u, 0u, 0u};
        if (mode != 0) l.m = *(const GAS u32x4*)(Mt + o);
        return l;
    }
    __device__ __forceinline__ void apply(int row, int c0, f32x4 v0, f32x4 v1, const L& l) const {
        const int o = (row - ro) * 256 + (c0 - co);
        const float k = 1.f / 255.f; const u32x2 g = l.g; const u32x4 m = l.m;
        f32x4 r0, r1;
        r0[0] = bflo(m.x) + (float)((g.x >> 0) & 0xffu) * k * v0[0]; r0[1] = bfhi(m.x) + (float)((g.x >> 8) & 0xffu) * k * v0[1];
        r0[2] = bflo(m.y) + (float)((g.x >> 16) & 0xffu) * k * v0[2]; r0[3] = bfhi(m.y) + (float)((g.x >> 24) & 0xffu) * k * v0[3];
        r1[0] = bflo(m.z) + (float)((g.y >> 0) & 0xffu) * k * v1[0]; r1[1] = bfhi(m.z) + (float)((g.y >> 8) & 0xffu) * k * v1[1];
        r1[2] = bflo(m.w) + (float)((g.y >> 16) & 0xffu) * k * v1[2]; r1[3] = bfhi(m.w) + (float)((g.y >> 24) & 0xffu) * k * v1[3];
        if (mode != 2) *(GAS u32x4*)(Mt + o) = pack8(r0, r1);
        else *(GAS u32x4*)(MG + (size_t)row * DM + c0) = pack8(r0, r1);
    }
};
struct FGateT3 {
    typedef NoLoad L;
    GAS unsigned char* Gt; int ro, co;
    __device__ __forceinline__ void begin() const {}
    __device__ __forceinline__ L load(int, int) const { return L{}; }
    __device__ __forceinline__ void apply(int row, int c0, f32x4 v0, f32x4 v1, const L&) const {
        const int j = c0 >> 10;
        u32x2 w; w.x = 0u; w.y = 0u;
        w.x = __builtin_amdgcn_cvt_pk_u8_f32(sigm(v0[0]) * 255.f, 0, w.x); w.x = __builtin_amdgcn_cvt_pk_u8_f32(sigm(v0[1]) * 255.f, 1, w.x);
        w.x = __builtin_amdgcn_cvt_pk_u8_f32(sigm(v0[2]) * 255.f, 2, w.x); w.x = __builtin_amdgcn_cvt_pk_u8_f32(sigm(v0[3]) * 255.f, 3, w.x);
        w.y = __builtin_amdgcn_cvt_pk_u8_f32(sigm(v1[0]) * 255.f, 0, w.y); w.y = __builtin_amdgcn_cvt_pk_u8_f32(sigm(v1[1]) * 255.f, 1, w.y);
        w.y = __builtin_amdgcn_cvt_pk_u8_f32(sigm(v1[2]) * 255.f, 2, w.y); w.y = __builtin_amdgcn_cvt_pk_u8_f32(sigm(v1[3]) * 255.f, 3, w.y);
        *(GAS u32x2*)(Gt + j * 65536 + (row - ro) * 256 + ((c0 & 1023) - co)) = w;
    }
};
struct FUpT3 {
    struct L { u32x2 g; u32x4 m; };
    const GAS unsigned char* Gt; GAS bf16_t* Mt; GAS bf16_t* MG; int ro, co;
    __device__ __forceinline__ void begin() const { l1_inv(); }
    __device__ __forceinline__ L load(int row, int c0) const {
        const int j = c0 >> 10; const int o = (row - j * T_TOK - ro) * 256 + ((c0 & 1023) - co);
        L l; l.g = *(const GAS u32x2*)(Gt + j * 65536 + o); l.m = (u32x4){0u, 0u, 0u, 0u};
        if (j != 0) l.m = *(const GAS u32x4*)(Mt + o);
        return l;
    }
    __device__ __forceinline__ void apply(int row, int c0, f32x4 v0, f32x4 v1, const L& l) const {
        const int j = c0 >> 10; const int rr = row - j * T_TOK, cc = c0 & 1023; const int o = (rr - ro) * 256 + (cc - co);
        const float k = 1.f / 255.f; const u32x2 g = l.g; const u32x4 m = l.m;
        f32x4 r0, r1;
        r0[0] = bflo(m.x) + (float)((g.x >> 0) & 0xffu) * k * v0[0]; r0[1] = bfhi(m.x) + (float)((g.x >> 8) & 0xffu) * k * v0[1];
        r0[2] = bflo(m.y) + (float)((g.x >> 16) & 0xffu) * k * v0[2]; r0[3] = bfhi(m.y) + (float)((g.x >> 24) & 0xffu) * k * v0[3];
        r1[0] = bflo(m.z) + (float)((g.y >> 0) & 0xffu) * k * v1[0]; r1[1] = bfhi(m.z) + (float)((g.y >> 8) & 0xffu) * k * v1[1];
        r1[2] = bflo(m.w) + (float)((g.y >> 16) & 0xffu) * k * v1[2]; r1[3] = bfhi(m.w) + (float)((g.y >> 24) & 0xffu) * k * v1[3];
        if (j != 2) *(GAS u32x4*)(Mt + o) = pack8(r0, r1);
        else *(GAS u32x4*)(MG + (size_t)rr * DM + cc) = pack8(r0, r1);
    }
};
struct EpiUpChain {
    static constexpr bool PERM = true, AFTER_DRAIN = false, CHAIN = true; static constexpr int MIDK = 0;
    const GAS unsigned char* Gt; GAS bf16_t* MG; int ro, co;
    __device__ __forceinline__ void operator()(const f32x4 (&)[2][2][4][2], const pg8::Unit&, int, int, int, int) const {}
    static __device__ __forceinline__ float gb(unsigned w, int sh) { return (float)max((w >> sh) & 0xffu, 1u); }
    __device__ __forceinline__ void chain(f32x4 (&acc)[2][2][4][2], const pg8::Unit& u, bool has_next, int wr, int wc, int fr, int fq) const {
        const int j = u.pn >> 2;
        const GAS unsigned char* ga_p = Gt + j * 65536 + (wr * 64 + fr) * 256 + wc * 32 + 8 * fq;
        if (has_next) {
#pragma unroll
            for (int h2 = 0; h2 < 2; ++h2) {
                u32x2 ga[8], gn[8];
#pragma unroll
                for (int m = 0; m < 4; ++m)
#pragma unroll
                    for (int bj = 0; bj < 2; ++bj) { const int o = (h2 * 128 + m * 16) * 256 + bj * 128; ga[2 * m + bj] = *(const GAS u32x2*)(ga_p + o); gn[2 * m + bj] = *(const GAS u32x2*)(ga_p + 65536 + o); }
#pragma unroll
                for (int m = 0; m < 4; ++m)
#pragma unroll
                    for (int bj = 0; bj < 2; ++bj) {
                        const u32x2 a = ga[2 * m + bj], n = gn[2 * m + bj];
                        f32x4 v0 = acc[h2][bj][m][0], v1 = acc[h2][bj][m][1];
                        v0[0] *= gb(a.x, 0) * __builtin_amdgcn_rcpf(gb(n.x, 0)); v0[1] *= gb(a.x, 8) * __builtin_amdgcn_rcpf(gb(n.x, 8));
                        v0[2] *= gb(a.x, 16) * __builtin_amdgcn_rcpf(gb(n.x, 16)); v0[3] *= gb(a.x, 24) * __builtin_amdgcn_rcpf(gb(n.x, 24));
                        v1[0] *= gb(a.y, 0) * __builtin_amdgcn_rcpf(gb(n.y, 0)); v1[1] *= gb(a.y, 8) * __builtin_amdgcn_rcpf(gb(n.y, 8));
                        v1[2] *= gb(a.y, 16) * __builtin_amdgcn_rcpf(gb(n.y, 16)); v1[3] *= gb(a.y, 24) * __builtin_amdgcn_rcpf(gb(n.y, 24));
                        acc[h2][bj][m][0] = v0; acc[h2][bj][m][1] = v1;
                    }
            }
        } else {
#pragma unroll
            for (int h2 = 0; h2 < 2; ++h2) {
                u32x2 ga[8];
#pragma unroll
                for (int m = 0; m < 4; ++m)
#pragma unroll
                    for (int bj = 0; bj < 2; ++bj) ga[2 * m + bj] = *(const GAS u32x2*)(ga_p + (h2 * 128 + m * 16) * 256 + bj * 128);
#pragma unroll
                for (int m = 0; m < 4; ++m)
#pragma unroll
                    for (int bj = 0; bj < 2; ++bj) {
                        const u32x2 a = ga[2 * m + bj]; const float k = 1.f / 255.f;
                        f32x4 v0 = acc[h2][bj][m][0], v1 = acc[h2][bj][m][1];
                        v0[0] *= gb(a.x, 0) * k; v0[1] *= gb(a.x, 8) * k; v0[2] *= gb(a.x, 16) * k; v0[3] *= gb(a.x, 24) * k;
                        v1[0] *= gb(a.y, 0) * k; v1[1] *= gb(a.y, 8) * k; v1[2] *= gb(a.y, 16) * k; v1[3] *= gb(a.y, 24) * k;
                        const int row = ro + wr * 64 + fr + h2 * 128 + m * 16, col = co + wc * 32 + 8 * fq + bj * 128;
                        *(GAS u32x4*)(MG + (size_t)row * DM + col) = pack8(v0, v1);
                    }
            }
        }
    }
};
struct EpiFf2 {
    static constexpr bool PERM = true, AFTER_DRAIN = false, CHAIN = false; static constexpr int MIDK = 4;
    const GAS bf16_t* XB; GAS bf16_t* PG;
    __device__ __forceinline__ void mid(f32x4 (&acc)[2][2][4][2], const pg8::Unit& u, int wr, int wc, int fr, int fq) const {
        const size_t base = (size_t)(u.pm * 256 + wr * 64 + fr) * DM + u.pn * 256 + wc * 32 + 8 * fq;
#pragma unroll
        for (int b = 0; b < 8; b += 4) {
            u32x4 g[8], x[8];
#pragma unroll
            for (int i = 0; i < 8; ++i) { const int bb = b + (i >> 1), bj = i & 1; const size_t o = base + (size_t)((bb >> 2) * 128 + (bb & 3) * 16) * DM + bj * 128; g[i] = *(const GAS u32x4*)(PG + o); x[i] = *(const GAS u32x4*)(XB + o); }
#pragma unroll
            for (int i = 0; i < 8; ++i) {
                const int bb = b + (i >> 1), bj = i & 1; const u32x4 gg = g[i], xx = x[i];
                f32x4 v0 = acc[bb >> 2][bj][bb & 3][0], v1 = acc[bb >> 2][bj][bb & 3][1];
                v0[0] = v0[0] * bflo(gg.x) + ALPHA * bflo(xx.x); v0[1] = v0[1] * bfhi(gg.x) + ALPHA * bfhi(xx.x); v0[2] = v0[2] * bflo(gg.y) + ALPHA * bflo(xx.y); v0[3] = v0[3] * bfhi(gg.y) + ALPHA * bfhi(xx.y);
                v1[0] = v1[0] * bflo(gg.z) + ALPHA * bflo(xx.z); v1[1] = v1[1] * bfhi(gg.z) + ALPHA * bfhi(xx.z); v1[2] = v1[2] * bflo(gg.w) + ALPHA * bflo(xx.w); v1[3] = v1[3] * bfhi(gg.w) + ALPHA * bfhi(xx.w);
                acc[bb >> 2][bj][bb & 3][0] = v0; acc[bb >> 2][bj][bb & 3][1] = v1;
            }
        }
        asm volatile("s_waitcnt vmcnt(0)" ::: "memory");
    }
    __device__ __forceinline__ void operator()(const f32x4 (&acc)[2][2][4][2], const pg8::Unit& u, int wr, int wc, int fr, int fq) const {
        const size_t base = (size_t)(u.pm * 256 + wr * 64 + fr) * DM + u.pn * 256 + wc * 32 + 8 * fq;
#pragma unroll
        for (int b = 0; b < 8; ++b)
#pragma unroll
            for (int bj = 0; bj < 2; ++bj)
                *(GAS u32x4*)(PG + base + (size_t)((b >> 2) * 128 + (b & 3) * 16) * DM + bj * 128) = pack8(acc[b >> 2][bj][b & 3][0], acc[b >> 2][bj][b & 3][1]);
    }
};
struct TriUnit {
    int pm, pn, dpm;
    __device__ __forceinline__ bool next(int i, pg8::Unit& o) const { if (i >= 3) return false; o.pm = pm + i * dpm; o.pn = pn + 4 * i; return true; }
    __device__ __forceinline__ void a_ready(const pg8::Unit&) const {}
    __device__ __forceinline__ void done(const pg8::Unit&) const {}
};
struct OneUnit {
    pg8::Unit u;
    __device__ __forceinline__ bool next(int i, pg8::Unit& o) const { if (i != 0) return false; o = u; return true; }
    __device__ __forceinline__ void a_ready(const pg8::Unit&) const {}
    __device__ __forceinline__ void done(const pg8::Unit&) const {}
};
struct FOut {
    struct L { u32x4 g; f32x4 a, b; };
    const GAS float* res; const GAS bf16_t* resb; GAS bf16_t* dst;
    __device__ __forceinline__ void begin() const {}
    __device__ __forceinline__ L load(int row, int c0) const {
        const size_t o = (size_t)row * DM + c0; L l; l.g = (u32x4){0u, 0u, 0u, 0u}; l.a = (f32x4){0.f, 0.f, 0.f, 0.f}; l.b = l.a;
        if (res) { l.a = *(const GAS f32x4*)(res + o); l.b = *(const GAS f32x4*)(res + o + 4); } else l.g = *(const GAS u32x4*)(resb + o);
        return l;
    }
    __device__ __forceinline__ void apply(int row, int c0, f32x4 v0, f32x4 v1, const L& l) const {
        const size_t o = (size_t)row * DM + c0;
        f32x4 a = l.a, b = l.b;
        if (!res) { const u32x4 g = l.g; a = (f32x4){bflo(g.x), bfhi(g.x), bflo(g.y), bfhi(g.y)}; b = (f32x4){bflo(g.z), bfhi(g.z), bflo(g.w), bfhi(g.w)}; }
        *(GAS u32x4*)(dst + o) = pack8(a * ALPHA + v0, b * ALPHA + v1);
    }
};
struct FFf1 {
    typedef NoLoad L;
    GAS bf16_t* HF; GAS bf16_t* PG;
    __device__ __forceinline__ void begin() const {}
    __device__ __forceinline__ L load(int, int) const { return L{}; }
    __device__ __forceinline__ void apply(int row, int c0, f32x4 v0, f32x4 v1, const L&) const {
        if (c0 < DFF) {
#pragma unroll
            for (int i = 0; i < 4; ++i) { const float a = fmaxf(v0[i], 0.f), b = fmaxf(v1[i], 0.f); v0[i] = a * a; v1[i] = b * b; }
            *(GAS u32x4*)(HF + (size_t)row * HFP + 256 + c0) = pack8(v0, v1);
        } else {
#pragma unroll
            for (int i = 0; i < 4; ++i) { v0[i] = sigm(v0[i]); v1[i] = sigm(v1[i]); }
            *(GAS u32x4*)(PG + (size_t)row * DM + (c0 - DFF)) = pack8(v0, v1);
        }
    }
};
struct FPle {
    struct L { u32x4 g; };
    GAS bf16_t* PG;
    __device__ __forceinline__ void begin() const {}
    __device__ __forceinline__ L load(int row, int c0) const { L l; l.g = *(const GAS u32x4*)(PG + (size_t)row * DM + c0); return l; }
    __device__ __forceinline__ void apply(int row, int c0, f32x4 v0, f32x4 v1, const L& l) const {
        const size_t o = (size_t)row * DM + c0; const u32x4 g = l.g;
        v0[0] *= bflo(g.x); v0[1] *= bfhi(g.x); v0[2] *= bflo(g.y); v0[3] *= bfhi(g.y);
        v1[0] *= bflo(g.z); v1[1] *= bfhi(g.z); v1[2] *= bflo(g.w); v1[3] *= bfhi(g.w);
        *(GAS u32x4*)(PG + o) = pack8(v0, v1);
    }
};
struct FFf2 {
    struct L { u32x4 g, x; };
    const GAS bf16_t* XB; GAS bf16_t* PG;
    __device__ __forceinline__ void begin() const { l1_inv(); }
    __device__ __forceinline__ L load(int row, int c0) const { const size_t o = (size_t)row * DM + c0; L l; l.g = *(const GAS u32x4*)(PG + o); l.x = *(const GAS u32x4*)(XB + o); return l; }
    __device__ __forceinline__ void apply(int row, int c0, f32x4 v0, f32x4 v1, const L& l) const {
        const size_t o = (size_t)row * DM + c0;
        const u32x4 g = l.g, x = l.x;
        f32x4 r0 = v0, r1 = v1;
        r0[0] += bflo(g.x) + ALPHA * bflo(x.x); r0[1] += bfhi(g.x) + ALPHA * bfhi(x.x); r0[2] += bflo(g.y) + ALPHA * bflo(x.y); r0[3] += bfhi(g.y) + ALPHA * bfhi(x.y);
        r1[0] += bflo(g.z) + ALPHA * bflo(x.z); r1[1] += bfhi(g.z) + ALPHA * bfhi(x.z); r1[2] += bflo(g.w) + ALPHA * bflo(x.w); r1[3] += bfhi(g.w) + ALPHA * bfhi(x.w);
        *(GAS u32x4*)(PG + o) = pack8(r0, r1);
    }
};
template <class F> __device__ __forceinline__ void run_gemm(LAS unsigned char* lds, const bf16_t* A, const bf16_t* Bt, int M, int N, int K, const F& f) {
    asm volatile("" : "+s"(K), "+s"(N), "+s"(M));
    pg8::Gemm g{A, Bt, M, N, K}; pg8::StaticOrder S; S.init(M, N, (int)gridDim.x, (int)blockIdx.x);
    EpiF<F> E{f};
    pg8::gemm_phase<EpiF<F>, pg8::StaticOrder, true, true>(lds, g, S, E);
}
template <class F> __device__ __forceinline__ void run_gemm_one(LAS unsigned char* lds, const bf16_t* A, const bf16_t* Bt, int M, int N, int K, pg8::Unit u, const F& f) {
    asm volatile("" : "+s"(K), "+s"(N), "+s"(M));
    pg8::Gemm g{A, Bt, M, N, K}; OneUnit S{u};
    EpiF<F> E{f};
    pg8::gemm_phase<EpiF<F>, OneUnit, true, true>(lds, g, S, E);
}
template <class F> __device__ __forceinline__ void run_gemm_tri(LAS unsigned char* lds, const bf16_t* A, const bf16_t* Bt, int M, int N, int K, TriUnit S, const F& f) {
    asm volatile("" : "+s"(K), "+s"(N), "+s"(M));
    pg8::Gemm g{A, Bt, M, N, K};
    EpiF<F> E{f};
    pg8::gemm_phase<EpiF<F>, TriUnit, true, true>(lds, g, S, E);
}
__device__ __forceinline__ void run_gemm_ff2(LAS unsigned char* lds, const bf16_t* A, const bf16_t* Bt, int M, int N, int K, const EpiFf2& E) {
    asm volatile("" : "+s"(K), "+s"(N), "+s"(M));
    pg8::Gemm g{A, Bt, M, N, K}; pg8::StaticOrder S; S.init(M, N, (int)gridDim.x, (int)blockIdx.x);
    pg8::gemm_phase<EpiFf2, pg8::StaticOrder, true, true>(lds, g, S, E);
}
__device__ __forceinline__ void run_gemm_chain(LAS unsigned char* lds, const bf16_t* A, const bf16_t* Bt, int M, int N, int K, TriUnit S, const EpiUpChain& E) {
    asm volatile("" : "+s"(K), "+s"(N), "+s"(M));
    pg8::Gemm g{A, Bt, M, N, K};
    pg8::gemm_phase<EpiUpChain, TriUnit, true, true>(lds, g, S, E);
}
__device__ __forceinline__ int win_src(int n) {
    if (n < 1152) return n;
    if (n < 2112) { const int e = n - 1152; return 1158 + e; }
    if (n < 2432) { const int e = n - 2112, hh = e >> 6, p = e & 63; return 2118 + hh * 64 + (p >> 1) + 32 * (p & 1); }
    if (n < 2496) { const int p = n - 2432; return 2438 + (p >> 1) + 32 * (p & 1); }
    if (n < 2560) return 2502 + (n - 2496);
    if (n < 3072) { const int e = n - 2560, hh = e >> 6, p = e & 63; return 2566 + hh * 64 + (p >> 1) + 32 * (p & 1); }
    if (n < 3136) { const int p = n - 3072; return 3078 + (p >> 1) + 32 * (p & 1); }
    if (n < 3142) return 1152 + (n - 3136);
    if (n < 3144) return -1;
    if (n < 3152) return 3142 + (n - 3144);
    return -1;
}
struct GWin { const float* W; __device__ __forceinline__ float operator()(int k, int n) const { const int s = win_src(n); return s < 0 ? 0.f : W[(size_t)k * CIN + s]; } };
struct GWg { const float* W; int j; __device__ __forceinline__ float operator()(int k, int n) const { return W[(size_t)k * CIN + 3150 + j * DM + n]; } };
struct GUp { const float* W; int kj; __device__ __forceinline__ float operator()(int k, int n) const { return k < kj ? W[(size_t)k * DM + n] : 0.f; } };
struct GPlain { const float* W; int pitch; __device__ __forceinline__ float operator()(int k, int n) const { return W[(size_t)k * pitch + n]; } };
struct GCat { const float* Wp; const float* Wf; __device__ __forceinline__ float operator()(int k, int n) const { return k < 256 ? Wp[(size_t)k * DM + n] : Wf[(size_t)(k - 256) * DM + n]; } };
struct GFf1 { const float* Wf; const float* Wp; __device__ __forceinline__ float operator()(int k, int n) const { return n < DFF ? Wf[(size_t)k * DFF + n] : Wp[(size_t)k * DM + (n - DFF)]; } };
template <class G> __device__ __forceinline__ void tr_item(const G& get, int K, int N, bf16_t* WT, LAS float* scr, int item, int lane) {
    const int nblk = N / 32, kb = item / nblk, nb = item % nblk, k0 = 64 * kb, n0 = 32 * nb;
#pragma unroll 8
    for (int i = 0; i < 32; ++i) { const int kk = 2 * i + (lane >> 5); scr[kk * 33 + (lane & 31)] = get(k0 + kk, n0 + (lane & 31)); }
    asm volatile("s_waitcnt lgkmcnt(0)" ::: "memory");
    const int c = lane & 7;
#pragma unroll
    for (int j = 0; j < 4; ++j) { const int n = (lane >> 3) + 8 * j; const LAS float* s = scr + (8 * c) * 33 + n;
        u32x4 o; o.x = cvtpk(s[0 * 33], s[1 * 33]); o.y = cvtpk(s[2 * 33], s[3 * 33]); o.z = cvtpk(s[4 * 33], s[5 * 33]); o.w = cvtpk(s[6 * 33], s[7 * 33]);
        *(u32x4*)(WT + (size_t)(n0 + n) * K + k0 + 8 * c) = o; }
    asm volatile("s_waitcnt lgkmcnt(0)" ::: "memory");
}
__device__ __forceinline__ void sincos_d(double x, double& s, double& c) {
    const double k = rint(x * 0.63661977236758134308);
    const double r = fma(-k, 6.123233995736766e-17, fma(-k, 1.5707963267948966, x));
    const double r2 = r * r;
    const double sp = r * (1.0 + r2 * (-1.0 / 6 + r2 * (1.0 / 120 + r2 * (-1.0 / 5040 + r2 * (1.0 / 362880 + r2 * (-1.0 / 39916800 + r2 * (1.0 / 6227020800.0)))))));
    const double cp = 1.0 + r2 * (-0.5 + r2 * (1.0 / 24 + r2 * (-1.0 / 720 + r2 * (1.0 / 40320 + r2 * (-1.0 / 3628800 + r2 * (1.0 / 479001600 + r2 * (-1.0 / 87178291200.0)))))));
    const int q = ((int)k) & 3;
    s = (q == 0) ? sp : (q == 1) ? cp : (q == 2) ? -sp : -cp;
    c = (q == 0) ? cp : (q == 1) ? -sp : (q == 2) ? -cp : sp;
}
struct Args { const float* in[16]; float* out; unsigned char* ws; };

__device__ __forceinline__ void prologue(LAS unsigned char* lds, const Args& a) {
    const int tid = opaque_tid(), lane = tid & 63, wid = __builtin_amdgcn_readfirstlane(tid >> 6);
    LAS float* scr = (LAS float*)(lds + wid * 16384);
    const int gw = blockIdx.x * 8 + wid, NGW = gridDim.x * 8;
    unsigned char* ws = a.ws;
    constexpr int I_IN = 16 * (NIN / 32), I_G = 3 * 512, I_UP = 3 * 192, I_OUT = 512, I_FF1 = 16 * (NFF1 / 32), I_FF2 = (HFP / 64) * 32, I_PLE = 0;
    constexpr int I_LAYER = I_IN + I_G + I_UP + I_OUT + I_FF1 + I_FF2 + I_PLE;
    for (int it = gw; it < 2 * I_LAYER; it += NGW) {
        const int L = it / I_LAYER; int r = it % I_LAYER;
        unsigned char* wl = ws + WS_W + (size_t)L * W_LAYER;
        if (r < I_IN) { tr_item(GWin{a.in[2] + (size_t)L * DM * CIN}, DM, NIN, (bf16_t*)(wl + WO_IN), scr, r, lane); continue; } r -= I_IN;
        if (r < I_G) { const int j = r / 512; tr_item(GWg{a.in[2] + (size_t)L * DM * CIN, j}, DM, DM, (bf16_t*)(wl + WO_G) + (size_t)j * DM * DM, scr, r % 512, lane); continue; } r -= I_G;
        if (r < I_UP) { const int j = r / 192; const int kj = j == 0 ? 384 : 320; const float* src = a.in[4 + j] + (size_t)L * kj * DM;
            tr_item(GUp{src, kj}, OCW, DM, (bf16_t*)(wl + WO_UP) + (size_t)j * DM * OCW, scr, r % 192, lane); continue; } r -= I_UP;
        if (r < I_OUT) { tr_item(GPlain{a.in[7] + (size_t)L * DM * DM, DM}, DM, DM, (bf16_t*)(wl + WO_OUT), scr, r, lane); continue; } r -= I_OUT;
        if (r < I_FF1) { tr_item(GFf1{a.in[10] + (size_t)L * DM * DFF, a.in[13] + (size_t)L * DM * DM}, DM, NFF1, (bf16_t*)(wl + WO_FF1), scr, r, lane); continue; } r -= I_FF1;
        tr_item(GCat{a.in[12] + (size_t)L * 256 * DM, a.in[11] + (size_t)L * DFF * DM}, HFP, DM, (bf16_t*)(wl + WO_FF2), scr, r, lane);
    }
    const size_t gt = (size_t)blockIdx.x * 512 + tid, NT = (size_t)gridDim.x * 512;
    {
        const f32x4* x4 = (const f32x4*)a.in[0]; u32x4* xb = (u32x4*)(ws + WS_XB);
        for (size_t i = gt; i < (size_t)T_TOK * DM / 8; i += NT) xb[i] = pack8(x4[2 * i], x4[2 * i + 1]);
        const f32x4* p4 = (const f32x4*)a.in[1]; u32x4* pb = (u32x4*)(ws + WS_PB);
        for (size_t i = gt; i < (size_t)2 * T_TOK * 256 / 8; i += NT) pb[i] = pack8(p4[2 * i], p4[2 * i + 1]);
    }
    {
        bf16_t* oc = (bf16_t*)(ws + WS_OC);
        for (size_t i = gt; i < (size_t)2 * T_TOK * 8; i += NT) { const size_t j = i / ((size_t)T_TOK * 8), rr = i % ((size_t)T_TOK * 8), row = rr >> 3, ch = rr & 7;
            *(u32x4*)(oc + (1 + j) * OC_STRIDE + row * OCW + 320 + ch * 8) = (u32x4){0u, 0u, 0u, 0u}; }
    }
    {
        float* cs = (float*)(ws + WS_TRIG);
        for (size_t e = gt; e < (size_t)SEQ * 32; e += NT) { const int pos = (int)(e >> 5), i = (int)(e & 31);
            double inv = 1.0; for (int t = 0; t < i; ++t) inv *= 0.7498942093324559;
            const float ang = (float)pos * (float)inv; double s, c; sincos_d((double)ang, s, c);
            cs[2 * e] = (float)c; cs[2 * e + 1] = (float)s; }
    }
}

__device__ __forceinline__ int next_unit(unsigned* ctr, LAS unsigned* slot) {
    __syncthreads();
    if (opaque_tid() == 0) *slot = atomicAdd(ctr, 1u);
    __syncthreads();
    return __builtin_amdgcn_readfirstlane((int)*slot);
}
__device__ __forceinline__ bf16x8 packf8(const f32x16& x, int s) {
    u32x4 w; w.x = cvtpk(x[8 * s], x[8 * s + 1]); w.y = cvtpk(x[8 * s + 2], x[8 * s + 3]); w.z = cvtpk(x[8 * s + 4], x[8 * s + 5]); w.w = cvtpk(x[8 * s + 6], x[8 * s + 7]);
    return __builtin_bit_cast(bf16x8, w);
}
template <int MODE>
__device__ __forceinline__ void attn_unit(LAS unsigned char* lds, const GAS bf16_t* __restrict__ HA, int b, int qb, int qcol, int kcol, int vcol,
                                          GAS bf16_t* __restrict__ O, int ocol, const GAS float* __restrict__ FL, float bfv, const GAS unsigned long long* __restrict__ MB) {
    const int tid = opaque_tid(), lane = tid & 63, r32 = lane & 31, hi = lane >> 5; const int wid = __builtin_amdgcn_readfirstlane(tid >> 6);
    LAS float* cbuf = (LAS float*)(lds + 36864); LAS float* wt = (LAS float*)(lds + 45056); LAS unsigned* flags = (LAS unsigned*)(lds + 45088);
    const size_t rowbase = (size_t)b * SEQ; const int qw = qb * 256 + wid * 32, q = qw + r32; const int ntiles = 4 * (qb + 1), td = qw >> 6;
    float cq = 0.f;
    if (MODE == 0) {
        float lf[4];
#pragma unroll
        for (int i = 0; i < 4; ++i) { const float x = FL[(rowbase + 4 * tid + i) * 8] + bfv; lf[i] = (fminf(x, 0.f) - __logf(1.f + __expf(-fabsf(x)))) * L2E; }
        const float s1 = lf[0], s2 = s1 + lf[1], s3 = s2 + lf[2], s4 = s3 + lf[3];
        float v = s4;
#pragma unroll
        for (int off = 1; off < 64; off <<= 1) { const float n = __shfl_up(v, off); if (lane >= off) v += n; }
        if (lane == 63) wt[wid] = v;
        __syncthreads();
        float base = 0.f;
#pragma unroll
        for (int w = 0; w < 8; ++w) { const float x = wt[w]; if (w < wid) base += x; }
        const float ex = base + v - s4;
        *(LAS f32x4*)(cbuf + 4 * tid) = (f32x4){ex + s1, ex + s2, ex + s3, ex + s4};
        __syncthreads();
        cq = cbuf[q];
    }
    if (MODE == 1) { if (tid < 8) flags[tid] = 0u; }
    bf16x8 qr[4];
    { const GAS bf16_t* qp = HA + (rowbase + q) * LDH + qcol + hi * 8;
#pragma unroll
      for (int d0 = 0; d0 < 4; ++d0) qr[d0] = *(const GAS bf16x8*)(qp + d0 * 16); }
    bf16x8 T0, T1, ONES;
    if (MODE == 1) {
#pragma unroll
        for (int j = 0; j < 8; ++j) { const int kk = 8 * (j >> 2) + 4 * hi + (j & 3); T0[j] = (kk > r32) ? (short)0x3F80 : (short)0; T1[j] = (16 + kk > r32) ? (short)0x3F80 : (short)0; ONES[j] = (short)0x3F80; }
    }
    LAS unsigned long long* mlds = (LAS unsigned long long*)(lds + 45568) + (wid * 32 + r32) * 33;
    if (MODE == 2) {
        const GAS unsigned long long* mbp = MB + (rowbase + q) * 32 + hi * 16;
        u32x4 mw[8];
#pragma unroll
        for (int i = 0; i < 8; ++i) mw[i] = *(const GAS u32x4*)(mbp + 2 * i);
#pragma unroll
        for (int i = 0; i < 8; ++i) { mlds[hi * 16 + 2 * i] = ((unsigned long long)mw[i].y << 32) | mw[i].x; mlds[hi * 16 + 2 * i + 1] = ((unsigned long long)mw[i].w << 32) | mw[i].z; }
    }
    f32x16 zero16;
#pragma unroll
    for (int i = 0; i < 16; ++i) zero16[i] = 0.f;
    f32x16 o0 = zero16, o1 = zero16;
    float m = 0.f, l = 0.f, R = 0.f; bool uns = true;
    const int skr = tid >> 3, sch = tid & 7;
    const GAS bf16_t* kg = HA + (rowbase + skr) * LDH + kcol + sch * 8;
    const GAS bf16_t* vg = HA + (rowbase + skr) * LDH + vcol + sch * 8;
    const int t_first = (MODE == 1) ? ntiles - 1 : 0;
    u32x4 kreg = *(const GAS u32x4*)(kg + (size_t)t_first * 64 * LDH), vreg = *(const GAS u32x4*)(vg + (size_t)t_first * 64 * LDH);
#define STAGE_TILE(bufi, KR, VR) do { LAS bf16_t* Ks_ = (LAS bf16_t*)(lds + (bufi) * 18432); LAS bf16_t* Vs_ = (LAS bf16_t*)(lds + (bufi) * 18432 + 9216); \
        *(LAS u32x4*)(Ks_ + skr * 72 + sch * 8) = KR; *(LAS u32x4*)(Vs_ + skr * 72 + sch * 8) = VR; } while (0)
#define VTR(p) __builtin_bit_cast(s16x4, __builtin_amdgcn_ds_read_tr16_b64_v4i16((LAS v4i16_t*)(p)))
#define VFRAG(dblk, kb) __builtin_shufflevector(VTR(vp + 16 * (kb) * 72 + 32 * (dblk)), VTR(vp + (16 * (kb) + 8) * 72 + 32 * (dblk)), 0, 1, 2, 3, 4, 5, 6, 7)
#define COMPUTE_TILE(T_, CUR_) do { const int t = (T_); const int cur = (CUR_); \
        if (t <= td) { \
            const LAS bf16_t* Ks = (const LAS bf16_t*)(lds + cur * 18432); const LAS bf16_t* Vt = (const LAS bf16_t*)(lds + cur * 18432 + 9216); \
            unsigned long long bits = 0ull; \
            if (MODE == 2) bits = mlds[t]; \
            const float init = (MODE == 1) ? 0.f : cq - m; \
            const int kbase = t * 64 + 4 * hi; \
            f32x16 p0, p1; \
            if (MODE == 0) { \
_Pragma("unroll") \
                for (int g = 0; g < 4; ++g) { \
                    const f32x4 c0 = *(const LAS f32x4*)(cbuf + kbase + 8 * g), c1 = *(const LAS f32x4*)(cbuf + kbase + 32 + 8 * g); \
_Pragma("unroll") \
                    for (int i = 0; i < 4; ++i) { p0[4 * g + i] = init - c0[i]; p1[4 * g + i] = init - c1[i]; } \
                } \
            } else if (MODE == 2) { \
                const unsigned blo = (unsigned)(bits >> (4 * hi)), bhi = (unsigned)(bits >> (32 + 4 * hi)); \
_Pragma("unroll") \
                for (int r = 0; r < 16; ++r) { const int ix = (r & 3) + 8 * (r >> 2); p0[r] = ((blo >> ix) & 1u) ? init : NEGF; p1[r] = ((bhi >> ix) & 1u) ? init : NEGF; } \
            } else { \
_Pragma("unroll") \
                for (int r = 0; r < 16; ++r) { p0[r] = 0.f; p1[r] = 0.f; } \
            } \
            { const LAS bf16_t* kp = Ks + r32 * 72 + hi * 8; \
_Pragma("unroll") \
              for (int d0 = 0; d0 < 4; ++d0) { \
                  const bf16x8 k0 = *(const LAS bf16x8*)(kp + d0 * 16), k1 = *(const LAS bf16x8*)(kp + 32 * 72 + d0 * 16); \
                  p0 = MFMA32(k0, qr[d0], p0); p1 = MFMA32(k1, qr[d0], p1); \
              } } \
            if (MODE == 1) { \
                f32x16 lb0, lb1; \
_Pragma("unroll") \
                for (int r = 0; r < 16; ++r) { \
                    const int k = kbase + (r & 3) + 8 * (r >> 2); \
                    { const float z = p0[r], sp = fmaxf(z, 0.f) + __builtin_amdgcn_logf(1.f + ex2(-fabsf(z))); float L = -sp, lb = z - sp; if (t == td && k >= q) { L = 0.f; lb = NEGF; } p0[r] = L; lb0[r] = lb; } \
                    { const float z = p1[r], sp = fmaxf(z, 0.f) + __builtin_amdgcn_logf(1.f + ex2(-fabsf(z))); float L = -sp, lb = z - sp; if (t == td && k + 32 >= q) { L = 0.f; lb = NEGF; } p1[r] = L; lb1[r] = lb; } \
                } \
                const bf16x8 L00 = packf8(p0, 0), L01 = packf8(p0, 1), L10 = packf8(p1, 0), L11 = packf8(p1, 1); \
                const f32x16 X1 = MFMA32(ONES, L10, MFMA32(ONES, L11, zero16)); \
                const f32x16 a0 = MFMA32(T0, L00, MFMA32(T1, L01, X1)); \
                const f32x16 a1 = MFMA32(T0, L10, MFMA32(T1, L11, zero16)); \
                const f32x16 tt = MFMA32(ONES, L00, MFMA32(ONES, L01, X1)); \
_Pragma("unroll") \
                for (int r = 0; r < 16; ++r) { p0[r] = ex2(lb0[r] + a0[r] + R); p1[r] = ex2(lb1[r] + a1[r] + R); } \
                R += tt[0]; \
            } else { \
                float mx = NEGF; \
                if (MODE == 0 && t == td) { \
_Pragma("unroll") \
                    for (int r = 0; r < 16; ++r) { const int k = kbase + (r & 3) + 8 * (r >> 2); if (k > q) p0[r] = NEGF; if (k + 32 > q) p1[r] = NEGF; } \
                } \
_Pragma("unroll") \
                for (int r = 0; r < 16; ++r) mx = fmaxf(mx, fmaxf(p0[r], p1[r])); \
                mx = fmaxf(mx, __shfl_xor(mx, 32)); \
 \
                float dl = 0.f, f = 1.f; \
                if (uns) { if (mx > -1e29f) { dl = mx; uns = false; } } \
                else if (mx > 8.f) { dl = mx; f = ex2(-dl); } \
                if (__any(dl != 0.f)) { \
                    m += dl; l *= f; \
_Pragma("unroll") \
                    for (int r = 0; r < 16; ++r) { o0[r] *= f; o1[r] *= f; p0[r] -= dl; p1[r] -= dl; } \
                } \
                float ps = 0.f; \
_Pragma("unroll") \
                for (int r = 0; r < 16; ++r) { p0[r] = ex2(p0[r]); p1[r] = ex2(p1[r]); ps += p0[r] + p1[r]; } \
                l += ps; \
            } \
 \
            const bf16x8 pb0 = packf8(p0, 0), pb1 = packf8(p0, 1), pb2 = packf8(p1, 0), pb3 = packf8(p1, 1); \
 \
            const LAS bf16_t* vp = Vt + (4 * hi + ((lane & 15) >> 2)) * 72 + 16 * ((lane >> 4) & 1) + 4 * (lane & 3); \
            o0 = MFMA32(VFRAG(0, 0), pb0, o0); o0 = MFMA32(VFRAG(0, 1), pb1, o0); o0 = MFMA32(VFRAG(0, 2), pb2, o0); o0 = MFMA32(VFRAG(0, 3), pb3, o0); \
            o1 = MFMA32(VFRAG(1, 0), pb0, o1); o1 = MFMA32(VFRAG(1, 1), pb1, o1); o1 = MFMA32(VFRAG(1, 2), pb2, o1); o1 = MFMA32(VFRAG(1, 3), pb3, o1); \
            if (MODE == 1) { if (__all(R < -160.f) && lane == 0) flags[wid] = 1u; } \
        } \
    } while (0)
#define LOAD_TILE(KR, VR, tl) do { KR = *(const GAS u32x4*)(kg + (size_t)(tl) * 64 * LDH); VR = *(const GAS u32x4*)(vg + (size_t)(tl) * 64 * LDH); } while (0)
#define TILE_OF(it_) ((MODE == 1) ? ntiles - 1 - (it_) : (it_))
    u32x4 kB, vB;
    STAGE_TILE(0, kreg, vreg);
    LOAD_TILE(kB, vB, TILE_OF(1));
    __syncthreads();
    bool stop = false;
    for (int it = 0; it < ntiles && !stop; it += 2) {
        LOAD_TILE(kreg, vreg, TILE_OF(min(it + 2, ntiles - 1)));
        COMPUTE_TILE(TILE_OF(it), 0);
        STAGE_TILE(1, kB, vB);
        __syncthreads();
        if (MODE == 1) { const u32x4 fa = *(const LAS u32x4*)flags, fb = *(const LAS u32x4*)(flags + 4); if ((fa.x & fa.y & fa.z & fa.w & fb.x & fb.y & fb.z & fb.w) != 0u) break; }
        LOAD_TILE(kB, vB, TILE_OF(min(it + 3, ntiles - 1)));
        COMPUTE_TILE(TILE_OF(it + 1), 1);
        STAGE_TILE(0, kreg, vreg);
        __syncthreads();
        if (MODE == 1) { const u32x4 fa = *(const LAS u32x4*)flags, fb = *(const LAS u32x4*)(flags + 4); if ((fa.x & fa.y & fa.z & fa.w & fb.x & fb.y & fb.z & fb.w) != 0u) stop = true; }
    }
#undef LOAD_TILE
#undef TILE_OF
#undef COMPUTE_TILE
#undef VTR
#undef VFRAG
#undef STAGE_TILE
    float inv = 1.f;
    if (MODE != 1) { const float lt = l + __shfl_xor(l, 32); inv = 1.f / lt; }
    GAS bf16_t* op = O + (rowbase + q) * OCW + ocol + 4 * hi;
#pragma unroll
    for (int g = 0; g < 4; ++g) {
        u32x2 w0, w1;
        w0.x = cvtpk(o0[4 * g] * inv, o0[4 * g + 1] * inv); w0.y = cvtpk(o0[4 * g + 2] * inv, o0[4 * g + 3] * inv);
        w1.x = cvtpk(o1[4 * g] * inv, o1[4 * g + 1] * inv); w1.y = cvtpk(o1[4 * g + 2] * inv, o1[4 * g + 3] * inv);
        *(GAS u32x2*)(op + 8 * g) = w0; *(GAS u32x2*)(op + 32 + 8 * g) = w1;
    }
}

__device__ __forceinline__ unsigned skey_of(float f) { const unsigned u = __float_as_uint(f); return u ^ ((unsigned)((int)u >> 31) | 0x80000000u); }
template <int NJ>
__device__ __forceinline__ void select_rows(const GAS float* sr0, GAS unsigned long long* mb0, LAS unsigned* hist, LAS unsigned* kbuf, int ntl, int lane) {
    unsigned vm = ntl >= 32 ? 0xffffffffu : ((1u << ntl) - 1u);
    asm volatile("" : "+v"(vm));
#pragma unroll 1
    for (int rr = 0; rr < 8; ++rr) {
        const GAS float* srow = sr0 + (size_t)rr * SEQ;
        float fv[NJ];
#pragma unroll
        for (int j = 0; j < NJ; ++j) fv[j] = srow[64 * j];
        { unsigned z = 0u; asm volatile("" : "+v"(z));
          *(LAS u32x4*)(hist + 4 * lane) = (u32x4){z, z, z, z}; if (lane < 2) hist[256 + lane] = z; }
        __builtin_amdgcn_wave_barrier();
        unsigned key[NJ];
#pragma unroll
        for (int j = 0; j < NJ; ++j) {
            const float f = fv[j]; const bool ok = (vm >> j) & 1u;
            key[j] = ok ? skey_of(f) : 0u;
            const int bk = min(max((int)floorf(f + f) + 128, 0), 255);
            __hip_atomic_fetch_add(hist + (ok ? bk : 256), 1u, __ATOMIC_RELAXED, __HIP_MEMORY_SCOPE_WORKGROUP);
        }
        __builtin_amdgcn_wave_barrier();
        asm volatile("s_waitcnt lgkmcnt(0)" ::: "memory");
        unsigned B, rem, C;
        {
            const u32x4 hv = *(const LAS u32x4*)(hist + 4 * lane);
            const unsigned s4 = hv.x + hv.y + hv.z + hv.w;
            unsigned S = s4;
#pragma unroll
            for (int off = 1; off < 64; off <<= 1) { const unsigned n = __shfl_down(S, off); if (lane + off < 64) S += n; }
            const unsigned excl = S - s4;
            const bool mine = (excl < 256u) && (256u <= S);
            unsigned dl, above, cnt, c = excl;
            if (c + hv.w >= 256u) { dl = 3; above = c; cnt = hv.w; } else { c += hv.w; if (c + hv.z >= 256u) { dl = 2; above = c; cnt = hv.z; } else { c += hv.z; if (c + hv.y >= 256u) { dl = 1; above = c; cnt = hv.y; } else { c += hv.y; dl = 0; above = c; cnt = hv.x; } } }
            const unsigned long long bm = __ballot(mine);
            const int src = bm ? (int)__builtin_ctzll(bm) : 0;
            B = (unsigned)__builtin_amdgcn_readlane((int)(4 * lane + dl), src);
            rem = 256u - (unsigned)__builtin_amdgcn_readlane((int)above, src);
            C = (unsigned)__builtin_amdgcn_readlane((int)cnt, src);
        }
        const unsigned klo = (B == 0u) ? 1u : skey_of((float)((int)B - 128) * 0.5f);
        const unsigned khi = (B == 255u) ? 0xffffffffu : skey_of((float)((int)B - 127) * 0.5f);
        const unsigned range = khi - klo;
        unsigned tau = 0u, remf = 0u, cnteq = 0u; bool generic = C > 64u;
        if (!generic) {
#pragma unroll
            for (int j = 0; j < NJ; ++j) {
                if ((key[j] - klo) < range) { const unsigned slot = __hip_atomic_fetch_add(hist + 257, 1u, __ATOMIC_RELAXED, __HIP_MEMORY_SCOPE_WORKGROUP); hist[258 + (slot & 63u)] = key[j]; }
            }
            __builtin_amdgcn_wave_barrier();
            asm volatile("s_waitcnt lgkmcnt(0)" ::: "memory");
            const bool have = (unsigned)lane < C;
            const unsigned mykey = have ? hist[258 + lane] : 0u;
            unsigned cgt = 0u;
            for (unsigned i = 0; i < C; ++i) { const unsigned o = (unsigned)__builtin_amdgcn_readlane((int)mykey, (int)i); cgt += (o > mykey) ? 1u : 0u; }
            unsigned t = (have && cgt < rem) ? mykey : 0xffffffffu;
#pragma unroll
            for (int o = 1; o < 64; o <<= 1) t = min(t, (unsigned)__shfl_xor((int)t, o));
            tau = t;
            const unsigned long long eqm = __ballot(have && mykey == tau);
            cnteq = (unsigned)__popcll(eqm);
            remf = rem - (unsigned)__builtin_amdgcn_readlane((int)cgt, eqm ? (int)__builtin_ctzll(eqm) : 0);
            generic = cnteq > remf;
        }
        unsigned mlo = 0u, mhi = 0u;
        if (!generic) {
#define WL1(J) if constexpr (J < NJ) { const unsigned long long w_ = __ballot(key[J] >= tau); const unsigned wl_ = (unsigned)w_, wh_ = (unsigned)(w_ >> 32); \
                asm volatile("s_nop 3\n\tv_writelane_b32 %0, %2, " #J "\n\tv_writelane_b32 %1, %3, " #J : "+v"(mlo), "+v"(mhi) : "s"(wl_), "s"(wh_)); }
            WL1(0) WL1(1) WL1(2) WL1(3) WL1(4) WL1(5) WL1(6) WL1(7) WL1(8) WL1(9) WL1(10) WL1(11) WL1(12) WL1(13) WL1(14) WL1(15)
            WL1(16) WL1(17) WL1(18) WL1(19) WL1(20) WL1(21) WL1(22) WL1(23) WL1(24) WL1(25) WL1(26) WL1(27) WL1(28) WL1(29) WL1(30) WL1(31)
#undef WL1
        } else {
#pragma unroll
            for (int j = 0; j < NJ; ++j) kbuf[64 * j + lane] = key[j];
            __builtin_amdgcn_wave_barrier();
            asm volatile("s_waitcnt lgkmcnt(0)" ::: "memory");
            unsigned pre = 0u;
            for (int bit = 31; bit >= 0; --bit) {
                const unsigned trial = pre | (1u << bit); unsigned cnt = 0u;
                for (int j = 0; j < NJ; ++j) cnt += (unsigned)__popcll(__ballot(kbuf[64 * j + lane] >= trial));
                if (cnt >= 256u) pre = trial;
            }
            unsigned cg = 0u;
            for (int j = 0; j < NJ; ++j) cg += (unsigned)__popcll(__ballot(kbuf[64 * j + lane] > pre));
            const unsigned take = 256u - cg; unsigned running = 0u;
            const unsigned long long lt_mask = (1ull << lane) - 1ull;
            for (int j = 0; j < NJ; ++j) {
                const unsigned k = kbuf[64 * j + lane];
                const bool eq = k == pre; const unsigned long long eqb = __ballot(eq);
                const unsigned before = running + (unsigned)__popcll(eqb & lt_mask);
                const unsigned long long w = __ballot(k > pre || (eq && before < take));
                running += (unsigned)__popcll(eqb);
                if (lane == j) { mlo = (unsigned)w; mhi = (unsigned)(w >> 32); }
            }
            __builtin_amdgcn_wave_barrier();
        }
        if (lane < 32) mb0[rr * 32 + lane] = ((unsigned long long)mhi << 32) | mlo;
    }
}

__device__ __forceinline__ unsigned sortable(float f) { unsigned u = __float_as_uint(f); if (u == 0x80000000u) u = 0u; return (u & 0x80000000u) ? ~u : (u | 0x80000000u); }
__device__ __forceinline__ void select_unit(LAS unsigned char* lds, const GAS bf16_t* __restrict__ HA, const GAS float* __restrict__ IW, int b, int qc, GAS float* __restrict__ scr, GAS unsigned long long* __restrict__ MB) {
    const int tid = opaque_tid(), lane = tid & 63, r32 = lane & 31, hi = lane >> 5; const int wid = __builtin_amdgcn_readfirstlane(tid >> 6);
    const size_t rowbase = (size_t)b * SEQ; const int ntl = qc + 1;
    if (ntl > 4) {
        const int c16 = lane & 15, lg = lane >> 4;
        const int ql = 16 * (wid & 3) + c16; const size_t qrow = rowbase + qc * 64 + ql;
        bf16x8 iqf[8][2]; float iwv[8];
        { const GAS bf16_t* qp = HA + qrow * LDH + 2560 + lg * 8;
#pragma unroll
          for (int hh = 0; hh < 8; ++hh) { iqf[hh][0] = *(const GAS bf16x8*)(qp + hh * 64); iqf[hh][1] = *(const GAS bf16x8*)(qp + hh * 64 + 32); }
          const f32x4 w0 = *(const GAS f32x4*)(IW + qrow * 8), w1 = *(const GAS f32x4*)(IW + qrow * 8 + 4);
          iwv[0] = w0[0]; iwv[1] = w0[1]; iwv[2] = w0[2]; iwv[3] = w0[3]; iwv[4] = w1[0]; iwv[5] = w1[1]; iwv[6] = w1[2]; iwv[7] = w1[3]; }
        const int nkb = 4 * ntl, nchunk = (ntl + 3) >> 2;
        const int srw = tid >> 3, sch = tid & 7;
        const GAS bf16_t* kgp = HA + (rowbase + srw) * LDH + 3072 + sch * 8;
        u32x4 kr[4];
#pragma unroll
        for (int i = 0; i < 4; ++i) if (i < ntl) kr[i] = *(const GAS u32x4*)(kgp + (size_t)(i * 64) * LDH);
#pragma unroll
        for (int i = 0; i < 4; ++i) if (i < ntl) *(LAS u32x4*)((LAS bf16_t*)lds + (i * 64 + srw) * 72 + sch * 8) = kr[i];
        __syncthreads();
        for (int c = 0; c < nchunk; ++c) {
            const int cur = c & 1; const bool more = c + 1 < nchunk;
            if (more) {
#pragma unroll
                for (int i = 0; i < 4; ++i) { const int tl = (c + 1) * 4 + i; if (tl < ntl) kr[i] = *(const GAS u32x4*)(kgp + (size_t)(tl * 64) * LDH); }
            }
            const LAS bf16_t* Kc = (const LAS bf16_t*)(lds + cur * 36864);
#pragma unroll 2
            for (int i = 0; i < 8; ++i) {
                const int kbl = (wid >> 2) + 2 * i, kb = c * 16 + kbl;
                if (kb < nkb) {
                    const LAS bf16_t* kp = Kc + (kbl * 16 + c16) * 72 + lg * 8;
                    const bf16x8 k0 = *(const LAS bf16x8*)kp, k1 = *(const LAS bf16x8*)(kp + 32);
                    f32x4 sc = (f32x4){0.f, 0.f, 0.f, 0.f};
#pragma unroll
                    for (int hh = 0; hh < 8; ++hh) {
                        f32x4 acc = __builtin_amdgcn_mfma_f32_16x16x32_bf16(k0, iqf[hh][0], (f32x4){0.f, 0.f, 0.f, 0.f}, 0, 0, 0);
                        acc = __builtin_amdgcn_mfma_f32_16x16x32_bf16(k1, iqf[hh][1], acc, 0, 0, 0);
#pragma unroll
                        for (int r = 0; r < 4; ++r) sc[r] += iwv[hh] * fmaxf(acc[r], 0.f);
                    }
                    *(GAS f32x4*)(scr + (size_t)ql * SEQ + kb * 16 + 4 * lg) = sc;
                }
            }
            if (more) {
#pragma unroll
                for (int i = 0; i < 4; ++i) { const int tl = (c + 1) * 4 + i; if (tl < ntl) *(LAS u32x4*)((LAS bf16_t*)(lds + (cur ^ 1) * 36864) + (i * 64 + srw) * 72 + sch * 8) = kr[i]; }
            }
            __syncthreads();
        }
    }
    asm volatile("s_waitcnt vmcnt(0)" ::: "memory");
    __syncthreads();
    l1_inv();
    GAS unsigned long long* mb0 = MB + (rowbase + qc * 64 + wid * 8) * 32;
    if (ntl <= 4) {
        for (int rr = 0; rr < 8; ++rr) if (lane < 32) mb0[rr * 32 + lane] = (lane < ntl) ? ~0ull : 0ull;
        return;
    }
    LAS unsigned* hist = (LAS unsigned*)(lds + 73728) + wid * 384;
    LAS unsigned* kbuf = (LAS unsigned*)lds + wid * 2048;
    const GAS float* sr0 = scr + (size_t)(wid * 8) * SEQ + lane;
    switch ((ntl + 7) >> 3) {
        case 1: select_rows<8>(sr0, mb0, hist, kbuf, ntl, lane); break;
        case 2: select_rows<16>(sr0, mb0, hist, kbuf, ntl, lane); break;
        case 3: select_rows<24>(sr0, mb0, hist, kbuf, ntl, lane); break;
        default: select_rows<32>(sr0, mb0, hist, kbuf, ntl, lane); break;
    }
}

__device__ __forceinline__ void ln_phase(const GAS bf16_t* Y, GAS bf16_t* XB, GAS float* OUT, const GAS float* g, const GAS float* bta, bool write_bf) {
    const int tid = opaque_tid(), lane = tid & 63, wid = tid >> 6;
    const int gw = blockIdx.x * 8 + wid, NGW = gridDim.x * 8;
    f32x4 gv[4], bv[4];
#pragma unroll
    for (int j = 0; j < 4; ++j) { gv[j] = *(const GAS f32x4*)(g + 4 * lane + 256 * j); bv[j] = *(const GAS f32x4*)(bta + 4 * lane + 256 * j); }
    constexpr int RB = 4;
    for (int row0 = gw; row0 < T_TOK; row0 += RB * NGW) {
        u32x2 w[RB][4];
#pragma unroll
        for (int r = 0; r < RB; ++r) { const int row = min(row0 + r * NGW, T_TOK - 1); const size_t ro = (size_t)row * DM + 4 * lane;
#pragma unroll
            for (int j = 0; j < 4; ++j) w[r][j] = __builtin_nontemporal_load((const GAS u32x2*)(Y + ro + 256 * j)); }
#pragma unroll
        for (int r = 0; r < RB; ++r) {
            const int row = row0 + r * NGW;
            if (row < T_TOK) {
                const size_t ro = (size_t)row * DM + 4 * lane;
                f32x4 v[4]; float s = 0.f;
#pragma unroll
                for (int j = 0; j < 4; ++j) { v[j] = (f32x4){bflo(w[r][j].x), bfhi(w[r][j].x), bflo(w[r][j].y), bfhi(w[r][j].y)}; s += (v[j][0] + v[j][1]) + (v[j][2] + v[j][3]); }
#pragma unroll
                for (int o = 1; o < 64; o <<= 1) s += __shfl_xor(s, o);
                const float mean = s * (1.f / DM); float s2 = 0.f;
#pragma unroll
                for (int j = 0; j < 4; ++j) { v[j] = v[j] - mean; s2 += (v[j][0] * v[j][0] + v[j][1] * v[j][1]) + (v[j][2] * v[j][2] + v[j][3] * v[j][3]); }
#pragma unroll
                for (int o = 1; o < 64; o <<= 1) s2 += __shfl_xor(s2, o);
                const float rstd = 1.f / sqrtf(s2 * (1.f / DM) + LN_EPS);
#pragma unroll
                for (int j = 0; j < 4; ++j) { const f32x4 y = v[j] * rstd * gv[j] + bv[j];
                    if (write_bf) { u32x2 o2; o2.x = cvtpk(y[0], y[1]); o2.y = cvtpk(y[2], y[3]); *(GAS u32x2*)(XB + ro + 256 * j) = o2; }
                    else __builtin_nontemporal_store(y, (GAS f32x4*)(OUT + ro + 256 * j)); }
            }
        }
    }
}

#define XB_TMO      128
#define XB_XCNT(j)  (256  + 64 * (j))
#define XB_XSUB(j)  (1280 + 64 * (j))
#define XB_XGEN(j)  (2304 + 64 * (j))
#define XB_TOP      3328
#define XB_TOPGEN   3392
#define XCD_BAR_WORDS 3456
#define XB_SPIN_CAP (1u << 18)

__device__ __forceinline__ unsigned xb_ld(unsigned* p)              { return __hip_atomic_load(p, __ATOMIC_RELAXED, __HIP_MEMORY_SCOPE_AGENT); }
__device__ __forceinline__ unsigned xb_add(unsigned* p, unsigned v) { return __hip_atomic_fetch_add(p, v, __ATOMIC_RELAXED, __HIP_MEMORY_SCOPE_AGENT); }
__device__ __forceinline__ unsigned xb_xcc_id() { return (unsigned)__builtin_amdgcn_s_getreg((3 << 11) | 20) & 0xFu; }
#define XB_SPIN(cond, bar) do { unsigned _sp = 0; while (cond) { __builtin_amdgcn_s_sleep(1); \
    if ((++_sp & 255u) == 0u) { if (xb_ld(&(bar)[XB_TMO])) break; if (_sp > XB_SPIN_CAP) { atomicAdd(&(bar)[XB_TMO], 1u); break; } } } } while (0)

struct XcdBarrier {
    unsigned* bar; unsigned x;
    volatile LAS unsigned* st;
};

__device__ __forceinline__ XcdBarrier xcd_barrier_post(unsigned* bar, volatile LAS unsigned* st) {
    XcdBarrier b; b.bar = bar; b.x = xb_xcc_id(); b.st = st;
    if (threadIdx.x == 0) (void)xb_add(&bar[XB_XCNT(b.x)], 1u);
    return b;
}
__device__ __forceinline__ void xcd_barrier_complete(unsigned* bar, unsigned x, unsigned& nloc, unsigned& nx) {
    const unsigned G = gridDim.x * gridDim.y * gridDim.z;
    unsigned sum, cnt, mine, sp = 0u;
    for (;;) {
        sum = 0u; cnt = 0u; mine = 0u;
#pragma unroll
        for (unsigned j = 0; j < 16; ++j) { const unsigned c = xb_ld(&bar[XB_XCNT(j)]); sum += c; cnt += (c > 0u) ? 1u : 0u; mine = (j == x) ? c : mine; }
        if (sum == G) break;
        __builtin_amdgcn_s_sleep(1);
        if ((++sp & 255u) == 0u) { if (xb_ld(&bar[XB_TMO])) break; if (sp > XB_SPIN_CAP) { atomicAdd(&bar[XB_TMO], 1u); break; } }
    }
    nloc = mine > 0u ? mine : 1u; nx = cnt > 0u ? cnt : 1u;
}

__device__ __forceinline__ void xcd_barrier(const XcdBarrier& b) {
    asm volatile("s_waitcnt vmcnt(0)" ::: "memory");
    __syncthreads();
    if (threadIdx.x == 0) {
        unsigned* bar = b.bar;
        __builtin_amdgcn_s_waitcnt(0);
        unsigned nloc = b.st[0], nx = b.st[1];
        if (nloc == 0u) { xcd_barrier_complete(bar, b.x, nloc, nx); b.st[0] = nloc; b.st[1] = nx; }
        const unsigned old = xb_add(&bar[XB_XSUB(b.x)], 1u);
        const unsigned gen = old / nloc;
        if (old + 1u == (gen + 1u) * nloc) {
            __builtin_amdgcn_fence(__ATOMIC_RELEASE, "agent");
            asm volatile("s_waitcnt vmcnt(0)" ::: "memory");
            const unsigned og = xb_add(&bar[XB_TOP], 1u);
            const unsigned tg = og / nx;
            if (og + 1u == (tg + 1u) * nx) xb_add(&bar[XB_TOPGEN], 1u);
            else XB_SPIN(xb_ld(&bar[XB_TOPGEN]) == tg, bar);
            __builtin_amdgcn_fence(__ATOMIC_ACQUIRE, "agent");
            xb_add(&bar[XB_XGEN(b.x)], 1u);
            asm volatile("s_waitcnt vmcnt(0)" ::: "memory");
        } else {
            XB_SPIN(xb_ld(&bar[XB_XGEN(b.x)]) == gen, bar);
            __builtin_amdgcn_fence(__ATOMIC_ACQUIRE, "agent");
            asm volatile("s_waitcnt vmcnt(0)" ::: "memory");
        }
    }
    __syncthreads();
}


__global__ void __launch_bounds__(512, 2) mega_fwd(Args a) {
    extern __shared__ __attribute__((aligned(16))) unsigned char lds_raw[];
    LAS unsigned char* lds = (LAS unsigned char*)lds_raw;
    LAS unsigned* slot = (LAS unsigned*)(lds + LDS_SLOT);
    cg::grid_group grid = cg::this_grid();
    volatile LAS unsigned* bst = (volatile LAS unsigned*)(lds + LDS_SLOT + 16);
    if (threadIdx.x < 2) bst[threadIdx.x] = 0u;
    __syncthreads();
    (void)xcd_barrier_post((unsigned*)(a.ws + WS_CTL) + 2048, bst);
#define GSYNC() do { XcdBarrier xb_; xb_.bar = (unsigned*)(KA->ws + WS_CTL) + 2048; xb_.x = xb_xcc_id(); xb_.st = (volatile LAS unsigned*)(lds + LDS_SLOT + 16); xcd_barrier(xb_); } while (0)
    const volatile __attribute__((address_space(4))) Args* KA = (const volatile __attribute__((address_space(4))) Args*)__builtin_amdgcn_kernarg_segment_ptr();
#define PH unsigned char* ws = KA->ws; int L = Lc; asm volatile("" : "+s"(ws), "+s"(L)); const unsigned char* wl = ws + WS_W + (size_t)L * W_LAYER; (void)wl
    prologue(lds, a);
    grid.sync();
    for (int Lc = 0; Lc < 2; ++Lc) {
        {
            PH;
            run_gemm(lds, (const bf16_t*)(ws + WS_XB), (const bf16_t*)(wl + WO_IN), T_TOK, NIN, DM, FIn{(GAS bf16_t*)(ws + WS_HA), (GAS float*)(ws + WS_FL), (GAS float*)(ws + WS_IW), (const GAS float*)(ws + WS_TRIG)});
        }
        GSYNC();
        {
            PH;
            unsigned* ctr = (unsigned*)(ws + WS_CTL) + 64 * (2 * L);
            const GAS float* bfg = (const GAS float*)KA->in[3] + L * 6;
            const GAS bf16_t* HA = (const GAS bf16_t*)(ws + WS_HA); const GAS float* FL = (const GAS float*)(ws + WS_FL); const GAS float* IW = (const GAS float*)(ws + WS_IW);
            GAS bf16_t* OC = (GAS bf16_t*)(ws + WS_OC); GAS unsigned long long* MB = (GAS unsigned long long*)(ws + WS_MB);
            GAS float* scr = (GAS float*)(ws + WS_SCR) + (size_t)blockIdx.x * 64 * SEQ;
            for (;;) {
                const int u = next_unit(ctr, slot); if (u >= 3840) break;
                const int lev = 7 - u / 480, rem = u % 480;
                if (rem < 192) { const int b = rem / 6, h = rem % 6; attn_unit<0>(lds, HA, b, lev, h * 64, 384 + h * 64, 768 + h * 64, OC, h * 64, FL + h, bfg[h], MB); }
                else if (rem < 352) { const int e = rem - 192, b = e / 5, h = e % 5; attn_unit<1>(lds, HA, b, lev, 1152 + h * 64, 1472 + h * 64, 1792 + h * 64, OC + OC_STRIDE, h * 64, FL, 0.f, MB); }
                else { const int s = rem - 352, qc = 4 * lev + 3 - (s >> 5), b = s & 31; select_unit(lds, HA, IW, b, qc, scr, MB); }
            }
        }
        GSYNC();
        {
            PH;
            unsigned* ctr = (unsigned*)(ws + WS_CTL) + 64 * (2 * L + 1);
            const GAS bf16_t* HA = (const GAS bf16_t*)(ws + WS_HA); GAS bf16_t* OC = (GAS bf16_t*)(ws + WS_OC); const GAS unsigned long long* MB = (const GAS unsigned long long*)(ws + WS_MB);
            for (;;) {
                const int u = next_unit(ctr, slot); if (u >= 1280) break;
                const int qb = 7 - u / 160, e = u % 160, b = e / 5, h = e % 5;
                attn_unit<2>(lds, HA, b, qb, 2112 + h * 64, 2432, 2496, OC + 2 * OC_STRIDE, h * 64, (const GAS float*)nullptr, 0.f, MB);
            }
        }
        GSYNC();
        for (int ui = 0; ui < 64; ++ui) {
            pg8::Unit u;
            { pg8::StaticOrder S; S.init(T_TOK, DM, (int)gridDim.x, (int)blockIdx.x); if (!S.next(ui, u)) break; }
            { PH;
              GAS unsigned char* Gt = (GAS unsigned char*)(ws + WS_MF + (size_t)blockIdx.x * 393216);
              run_gemm_tri(lds, (const bf16_t*)(ws + WS_XB), (const bf16_t*)(wl + WO_G), T_TOK, 3 * DM, DM, TriUnit{u.pm, u.pn, 0}, FGateT3{Gt, 256 * u.pm, 256 * u.pn}); }
            { PH;
              GAS unsigned char* Gt = (GAS unsigned char*)(ws + WS_MF + (size_t)blockIdx.x * 393216);
              l1_inv();
              run_gemm_chain(lds, (const bf16_t*)(ws + WS_OC), (const bf16_t*)(wl + WO_UP), 3 * T_TOK, 3 * DM, OCW, TriUnit{u.pm, u.pn, 256},
                             EpiUpChain{Gt, (GAS bf16_t*)(ws + WS_G), 256 * u.pm, 256 * u.pn}); }
        }
        GSYNC();
        {
            PH;
            run_gemm(lds, (const bf16_t*)(ws + WS_G), (const bf16_t*)(wl + WO_OUT), T_TOK, DM, DM, FOut{L == 0 ? (const GAS float*)KA->in[0] : (const GAS float*)nullptr, (const GAS bf16_t*)(ws + WS_XB), (GAS bf16_t*)(ws + WS_PG)});
        }
        GSYNC();
        {
            PH;
            ln_phase((const GAS bf16_t*)(ws + WS_PG), (GAS bf16_t*)(ws + WS_XB), (GAS float*)KA->out, (const GAS float*)KA->in[8] + L * DM, (const GAS float*)KA->in[9] + L * DM, true);
            const GAS u32x4* ps = (const GAS u32x4*)(ws + WS_PB) + (size_t)L * T_TOK * 32; GAS bf16_t* hf = (GAS bf16_t*)(ws + WS_HFF);
            for (size_t i = (size_t)blockIdx.x * 512 + opaque_tid(); i < (size_t)T_TOK * 32; i += (size_t)gridDim.x * 512) *(GAS u32x4*)(hf + (i >> 5) * HFP + (i & 31) * 8) = ps[i];
        }
        GSYNC();
        {
            PH;
            run_gemm(lds, (const bf16_t*)(ws + WS_XB), (const bf16_t*)(wl + WO_FF1), T_TOK, NFF1, DM, FFf1{(GAS bf16_t*)(ws + WS_HFF), (GAS bf16_t*)(ws + WS_PG)});
        }
        GSYNC();
        {
            PH;
            run_gemm_ff2(lds, (const bf16_t*)(ws + WS_HFF), (const bf16_t*)(wl + WO_FF2), T_TOK, DM, HFP, EpiFf2{(const GAS bf16_t*)(ws + WS_XB), (GAS bf16_t*)(ws + WS_PG)});
        }
        GSYNC();
        {
            PH;
            ln_phase((const GAS bf16_t*)(ws + WS_PG), (GAS bf16_t*)(ws + WS_XB), (GAS float*)KA->out, (const GAS float*)KA->in[14] + L * DM, (const GAS float*)KA->in[15] + L * DM, L == 0);
        }
        if (Lc == 0) GSYNC();
    }
#undef PH
}

extern "C" void kernel_launch(void* const* d_in, const int* in_sizes, int n_in, void* d_out, int out_size, void* d_ws, size_t ws_size, hipStream_t stream) {
    static int grid_blocks = 0;
    if (grid_blocks == 0) {
        if (n_in != 16 || out_size != T_TOK * DM || ws_size < WS_END) { fprintf(stderr, "kernel_launch: unexpected problem (n_in %d out %d ws %zu, need %zu)\n", n_in, out_size, ws_size, (size_t)WS_END); grid_blocks = -1; return; }
        int dev = 0, cus = 0, per_cu = 0;
        hipGetDevice(&dev);
        hipDeviceGetAttribute(&cus, hipDeviceAttributeMultiprocessorCount, dev);
        hipFuncSetAttribute((const void*)mega_fwd, hipFuncAttributeMaxDynamicSharedMemorySize, LDS_BYTES);
        hipOccupancyMaxActiveBlocksPerMultiprocessor(&per_cu, (const void*)mega_fwd, 512, LDS_BYTES);
        if (per_cu < 1) { fprintf(stderr, "kernel_launch: occupancy query returned %d\n", per_cu); per_cu = 1; }
        grid_blocks = cus * per_cu;
        (void)hipGetLastError();
    }
    if (grid_blocks < 0) return;
    hipMemsetAsync((char*)d_ws + WS_CTL, 0, 32768, stream);
    Args a{};
    for (int i = 0; i < 16; ++i) a.in[i] = (const float*)d_in[i];
    a.out = (float*)d_out; a.ws = (unsigned char*)d_ws;
    void* args[] = {&a};
    hipError_t e = hipLaunchCooperativeKernel((const void*)mega_fwd, dim3(grid_blocks), dim3(512), args, LDS_BYTES, stream);
    if (e != hipSuccess) fprintf(stderr, "cooperative launch failed: %s (grid %d)\n", hipGetErrorString(e), grid_blocks);
}
```

```cpp
#include <hip/hip_runtime.h>
#include <hip/hip_cooperative_groups.h>
#include <cstdio>
#include <cstdint>
namespace cg = cooperative_groups;
__device__ __forceinline__ int opaque_tid() { int t = (int)threadIdx.x; asm volatile("" : "+v"(t)); return t; }
namespace pg8 {
#define PG8_LAS __attribute__((address_space(3)))
typedef unsigned short bf16_t;
typedef short bf16x8 __attribute__((ext_vector_type(8)));
typedef float f32x4 __attribute__((ext_vector_type(4)));
typedef unsigned u32x4 __attribute__((ext_vector_type(4)));
constexpr int BM = 256, BK = 64, HALF = 128, HTB = HALF * BK * 2, STAGE_BYTES = 8 * HTB, NXCD = 8, WGM = 4;

__host__ __device__ __forceinline__ int lds_byte(int r, int c) { const int st = (r >> 4) * 2 + (c >> 5), rr = r & 15, cc = c & 31, ob = rr * 64 + cc * 2; return st * 1024 + (ob ^ (((ob >> 9) & 1) << 5)); }
__host__ __device__ __forceinline__ void stage_rc(int b, int& R, int& C) { const int st = b / 1024, sb = b % 1024, swz = sb ^ (((sb >> 9) & 1) << 5); R = (st >> 1) * 16 + swz / 64; C = (st & 1) * 32 + (swz % 64) / 2; }
__host__ __device__ __forceinline__ int perm32(int rho) { const int n = rho >> 4, i = rho & 15; return 8 * (i >> 2) + 4 * n + (i & 3); }

struct Unit { int pm, pn; };
struct Gemm { const bf16_t* A; const bf16_t* Bt; int M, N, K; };

struct StaticOrder {
    int nM, nN, nwg, G, c;
    __host__ __device__ __forceinline__ void init(int M, int N, int G_, int c_) { nM = M / BM; nN = N / BM; nwg = nM * nN; G = G_; c = c_; }
    __host__ __device__ __forceinline__ bool next(int i, Unit& u) const {
        const long L = (long)i * G + c; if (L >= nwg) return false;
        int wgid = (int)L; { const int q = nwg / NXCD, r = nwg % NXCD, xcd = wgid % NXCD, off = wgid / NXCD; wgid = (xcd < r ? xcd * (q + 1) : r * (q + 1) + (xcd - r) * q) + off; }
        const int nig = WGM * nN, gid = wgid / nig, fm = gid * WGM, gsz = (nM - fm) < WGM ? (nM - fm) : WGM;
        u.pm = fm + ((wgid % nig) % gsz); u.pn = (wgid % nig) / gsz; return true;
    }
    __device__ __forceinline__ void a_ready(const Unit&) const {}
    __device__ __forceinline__ void done(const Unit&) const {}
};

template <class Epi, class Sched, bool ALIGN_EPI = false, bool SP2 = false>
__device__ __forceinline__ void gemm_phase(PG8_LAS unsigned char* lds, const Gemm g, const Sched& S, const Epi& E) {
    const int tid = opaque_tid(), wid = __builtin_amdgcn_readfirstlane(tid >> 6), lane = tid & 63, wr = wid >> 2, wc = wid & 3, fr = lane & 15, fq = lane >> 4;
    const int K = g.K, nt = K / BK;
    unsigned voffA[2], voffB[2];
#pragma unroll
    for (int i = 0; i < 2; ++i) { int R, C; stage_rc(tid * 16 + i * 8192, R, C); const int Rb = Epi::PERM ? ((R & ~31) + perm32(R & 31)) : R;
        voffA[i] = (unsigned)(R * K + C) * 2u; voffB[i] = (unsigned)(Rb * K + C) * 2u; }
    const size_t kstep = (size_t)(BK * 2);
    const size_t hstep = (size_t)HALF * K * 2;
    const size_t tstep = 2 * hstep;
    const unsigned ldsw = (unsigned)wid * 1024u;
    const int aoff = lds_byte(wr * 64 + fr, fq * 8), boff = lds_byte(wc * 32 + fr, fq * 8);
#define PG8_SA(b, h) (((b) * 2 + (h)) * HTB)
#define PG8_SB(b, h) ((4 + (b) * 2 + (h)) * HTB)
#define PG8_STAGE(bufoff, gbase, voff) do { _Pragma("unroll") for (int _i = 0; _i < 2; ++_i) \
        __builtin_amdgcn_global_load_lds((const unsigned*)((const char*)(gbase) + (voff)[_i]), (PG8_LAS unsigned*)(lds + (bufoff) + ldsw + _i * 8192), 16, 0, 0); } while (0)
#define PG8_LDA(dst, b, h) do { _Pragma("unroll") for (int m = 0; m < 4; ++m) _Pragma("unroll") for (int k = 0; k < 2; ++k) dst[m][k] = *(const PG8_LAS bf16x8*)(lds + PG8_SA(b, h) + aoff + m * 2048 + k * 1024); } while (0)
#define PG8_LDB(dst, b, h) do { _Pragma("unroll") for (int n = 0; n < 2; ++n) _Pragma("unroll") for (int k = 0; k < 2; ++k) dst[n][k] = *(const PG8_LAS bf16x8*)(lds + PG8_SB(b, h) + boff + n * 2048 + k * 1024); } while (0)
#define PG8_MMA(ai, bj, At, Bt) do { __builtin_amdgcn_s_setprio(1); _Pragma("unroll") for (int m = 0; m < 4; ++m) _Pragma("unroll") for (int n = 0; n < 2; ++n) _Pragma("unroll") for (int k = 0; k < 2; ++k) \
        acc[ai][bj][m][n] = __builtin_amdgcn_mfma_f32_16x16x32_bf16(Bt[n][k], At[m][k], acc[ai][bj][m][n], 0, 0, 0); __builtin_amdgcn_s_setprio(0); } while (0)
#define PG8_WAIT_V(n) asm volatile("s_waitcnt vmcnt(" #n ")" ::: "memory")
#define PG8_WAIT_L(n) asm volatile("s_waitcnt lgkmcnt(" #n ")" ::: "memory")
#define PG8_BAR __builtin_amdgcn_s_barrier()
#define PG8_SCHED __builtin_amdgcn_sched_barrier(0)
    Unit cur, nxt; int ui = 0;
    if (!S.next(0, cur)) return;
    f32x4 acc[2][2][4][2];
#pragma unroll
    for (int a = 0; a < 2; ++a)
#pragma unroll
        for (int b = 0; b < 2; ++b)
#pragma unroll
            for (int m = 0; m < 4; ++m)
#pragma unroll
                for (int n = 0; n < 2; ++n) acc[a][b][m][n] = (f32x4){0.f, 0.f, 0.f, 0.f};
    bf16x8 At[4][2], B0[2][2], B1[2][2];
    const char* cA = (const char*)g.A + (size_t)cur.pm * tstep; const char* cB = (const char*)g.Bt + (size_t)cur.pn * tstep;
    S.a_ready(cur);
    if constexpr (SP2) {
        PG8_STAGE(PG8_SB(0, 0), cB, voffB); PG8_STAGE(PG8_SB(0, 1), cB + hstep, voffB); PG8_STAGE(PG8_SA(0, 0), cA, voffA); PG8_STAGE(PG8_SA(0, 1), cA + hstep, voffA);
        if (wr == 1) PG8_BAR;
        PG8_WAIT_V(2); PG8_BAR;
        PG8_STAGE(PG8_SB(1, 0), cB + kstep, voffB); PG8_STAGE(PG8_SA(1, 0), cA + kstep, voffA); PG8_STAGE(PG8_SB(1, 1), cB + hstep + kstep, voffB);
        PG8_WAIT_V(6); PG8_BAR;
    } else {
        PG8_STAGE(PG8_SB(0, 0), cB, voffB); PG8_STAGE(PG8_SA(0, 0), cA, voffA); PG8_STAGE(PG8_SB(0, 1), cB + hstep, voffB); PG8_STAGE(PG8_SA(0, 1), cA + hstep, voffA);
        if (wr == 1) PG8_BAR;
        PG8_WAIT_V(4); PG8_BAR;
        PG8_STAGE(PG8_SB(1, 0), cB + kstep, voffB); PG8_STAGE(PG8_SA(1, 0), cA + kstep, voffA); PG8_STAGE(PG8_SB(1, 1), cB + hstep + kstep, voffB);
        PG8_WAIT_V(6); PG8_BAR;
    }
    for (;;) {
        const bool has_next = S.next(ui + 1, nxt);
        const char* nA = has_next ? (const char*)g.A + (size_t)nxt.pm * tstep : cA; const char* nB = has_next ? (const char*)g.Bt + (size_t)nxt.pn * tstep : cB;
        constexpr int NSEG = Epi::MIDK > 0 ? 2 : 1;
#pragma unroll
        for (int seg = 0; seg < NSEG; ++seg) {
        const int t0 = (NSEG == 2 && seg == 1) ? Epi::MIDK : 0, t1 = (NSEG == 2 && seg == 0) ? Epi::MIDK : nt;
        if constexpr (Epi::MIDK > 0) { if (seg == 1) E.mid(acc, cur, wr, wc, fr, fq); }
#pragma unroll 1
        for (int t = t0; t < t1; t += 2) {
            const bool last = (t == nt - 2);
            const char* a1 = cA + (size_t)(t + 1) * kstep;
            const char* a2 = last ? nA : cA + (size_t)(t + 2) * kstep; const char* b2 = last ? nB : cB + (size_t)(t + 2) * kstep;
            const char* a3 = a2 + kstep; const char* b3 = b2 + kstep;
            if (last && has_next) S.a_ready(nxt);
            if constexpr (SP2) {
            PG8_LDB(B0, 0, 0); PG8_LDB(B1, 0, 1); PG8_SCHED; PG8_LDA(At, 0, 0); PG8_STAGE(PG8_SA(1, 1), a1 + hstep, voffA);
            PG8_WAIT_V(8); PG8_WAIT_L(0); PG8_BAR; PG8_MMA(0, 0, At, B0); PG8_MMA(0, 1, At, B1); PG8_BAR; PG8_SCHED;
            PG8_LDA(At, 0, 1); PG8_STAGE(PG8_SB(0, 0), b2, voffB); PG8_STAGE(PG8_SB(0, 1), b2 + hstep, voffB); PG8_STAGE(PG8_SA(0, 0), a2, voffA);
            PG8_WAIT_V(8); PG8_WAIT_L(0); PG8_BAR; PG8_MMA(1, 0, At, B0); PG8_MMA(1, 1, At, B1); PG8_BAR; PG8_SCHED;
            PG8_LDB(B0, 1, 0); PG8_LDB(B1, 1, 1); PG8_SCHED; PG8_LDA(At, 1, 0); PG8_STAGE(PG8_SA(0, 1), a2 + hstep, voffA);
            PG8_WAIT_V(8); PG8_WAIT_L(0); PG8_BAR; PG8_MMA(0, 0, At, B0); PG8_MMA(0, 1, At, B1); PG8_BAR; PG8_SCHED;
            PG8_LDA(At, 1, 1); PG8_STAGE(PG8_SB(1, 0), b3, voffB); PG8_STAGE(PG8_SB(1, 1), b3 + hstep, voffB); PG8_STAGE(PG8_SA(1, 0), a3, voffA);
            PG8_WAIT_V(8); PG8_WAIT_L(0); PG8_BAR; PG8_MMA(1, 0, At, B0); PG8_MMA(1, 1, At, B1); PG8_BAR; PG8_SCHED;
            } else {
            PG8_LDB(B0, 0, 0); PG8_SCHED; PG8_LDA(At, 0, 0); PG8_STAGE(PG8_SA(1, 1), a1 + hstep, voffA);
            PG8_WAIT_L(8); PG8_BAR; PG8_WAIT_L(0); PG8_MMA(0, 0, At, B0); PG8_BAR; PG8_SCHED;
            PG8_LDB(B1, 0, 1); PG8_STAGE(PG8_SB(0, 0), b2, voffB);
            PG8_BAR; PG8_WAIT_L(0); PG8_MMA(0, 1, At, B1); PG8_BAR;
            PG8_LDA(At, 0, 1); PG8_STAGE(PG8_SA(0, 0), a2, voffA);
            PG8_BAR; PG8_WAIT_L(0); PG8_MMA(1, 0, At, B0); PG8_BAR; PG8_SCHED;
            PG8_STAGE(PG8_SB(0, 1), b2 + hstep, voffB);
            PG8_WAIT_V(6); PG8_BAR; PG8_MMA(1, 1, At, B1); PG8_BAR;
            PG8_LDB(B0, 1, 0); PG8_SCHED; PG8_LDA(At, 1, 0); PG8_STAGE(PG8_SA(0, 1), a2 + hstep, voffA);
            PG8_WAIT_L(8); PG8_BAR; PG8_WAIT_L(0); PG8_MMA(0, 0, At, B0); PG8_BAR; PG8_SCHED;
            PG8_LDB(B1, 1, 1); PG8_STAGE(PG8_SB(1, 0), b3, voffB);
            PG8_BAR; PG8_WAIT_L(0); PG8_MMA(0, 1, At, B1); PG8_BAR;
            PG8_LDA(At, 1, 1); PG8_STAGE(PG8_SA(1, 0), a3, voffA);
            PG8_BAR; PG8_WAIT_L(0); PG8_MMA(1, 0, At, B0); PG8_BAR; PG8_SCHED;
            PG8_STAGE(PG8_SB(1, 1), b3 + hstep, voffB);
            PG8_WAIT_V(6); PG8_BAR; PG8_MMA(1, 1, At, B1); PG8_BAR;
            }
        }
        }
        if constexpr (ALIGN_EPI) { if (wr == 0) PG8_BAR; }
        if constexpr (Epi::CHAIN) {
            E.chain(acc, cur, has_next, wr, wc, fr, fq); S.done(cur);
            if (!has_next) break;
        } else {
        if constexpr (!Epi::AFTER_DRAIN) { E(acc, cur, wr, wc, fr, fq); S.done(cur); }
        if (!has_next) break;
#pragma unroll
        for (int a = 0; a < 2; ++a)
#pragma unroll
            for (int b = 0; b < 2; ++b)
#pragma unroll
                for (int m = 0; m < 4; ++m)
#pragma unroll
                    for (int n = 0; n < 2; ++n) acc[a][b][m][n] = (f32x4){0.f, 0.f, 0.f, 0.f};
        }
        cur = nxt; cA = nA; cB = nB; ++ui;
        if constexpr (ALIGN_EPI) { if (wr == 1) PG8_BAR; }
    }
    PG8_WAIT_V(0);
    if constexpr (!ALIGN_EPI) { if (wr == 0) PG8_BAR; }
    PG8_BAR;
    if constexpr (Epi::AFTER_DRAIN) { E.fused(acc, cur, wr, wc, fr, fq, lds, wid, lane); S.done(cur); }
#undef PG8_SA
#undef PG8_SB
#undef PG8_STAGE
#undef PG8_LDA
#undef PG8_LDB
#undef PG8_MMA
#undef PG8_WAIT_V
#undef PG8_WAIT_L
#undef PG8_BAR
#undef PG8_SCHED
}
}
using pg8::bf16_t; using pg8::bf16x8; using pg8::f32x4; using pg8::u32x4;
#define LAS __attribute__((address_space(3)))
#define GAS __attribute__((address_space(1)))
typedef float f32x16 __attribute__((ext_vector_type(16)));
typedef short s16x4 __attribute__((ext_vector_type(4)));
typedef float f32x2_t __attribute__((ext_vector_type(2)));
typedef __bf16 bf16x2_t __attribute__((ext_vector_type(2)));
typedef unsigned u32x2 __attribute__((ext_vector_type(2)));
typedef short v4i16_t __attribute__((ext_vector_type(4)));
#define MFMA32(a, b, c) __builtin_amdgcn_mfma_f32_32x32x16_bf16((a), (b), (c), 0, 0, 0)

constexpr int T_TOK = 65536, SEQ = 2048, DM = 1024, LDH = 3136, NIN = 3328, CIN = 6222, DFF = 4096, NFF1 = 5120, OCW = 384, HFP = 256 + DFF;
constexpr float ALPHA = 1.4142135623730951f, L2E = 1.4426950408889634f, LN_EPS = 1e-5f, NEGF = -1e30f;
constexpr size_t MiB = (size_t)1 << 20;
constexpr size_t WS_CTL = 0, WS_TRIG = 1 * MiB, WS_W = 2 * MiB, W_LAYER = 40 * MiB;
constexpr size_t WO_IN = 0, WO_G = 7 * MiB, WO_UP = 13 * MiB, WO_OUT = 16 * MiB, WO_FF1 = 18 * MiB, WO_FF2 = 28 * MiB, WO_PLE = 36 * MiB;
constexpr size_t WS_PB = 82 * MiB, WS_MB = 146 * MiB, WS_FL = 162 * MiB, WS_IW = 164 * MiB, WS_XB = 166 * MiB, WS_OC = 294 * MiB, WS_A = 438 * MiB;
constexpr size_t WS_HA = WS_A, WS_SCR = WS_A + 392 * MiB, WS_HFF = WS_A, WS_MF = WS_A, WS_G = WS_A + 256 * MiB, WS_PG = WS_OC, WS_END = 984 * MiB;
constexpr size_t OC_STRIDE = (size_t)T_TOK * OCW;
constexpr int LDS_SLOT = 131072, LDS_BYTES = 131072 + 256;

__device__ __forceinline__ unsigned cvtpk(float lo, float hi) { f32x2_t v = {lo, hi}; bf16x2_t b = __builtin_convertvector(v, bf16x2_t); return __builtin_bit_cast(unsigned, b); }
__device__ __forceinline__ float bflo(unsigned w) { return __uint_as_float(w << 16); }
__device__ __forceinline__ float bfhi(unsigned w) { return __uint_as_float(w & 0xffff0000u); }
__device__ __forceinline__ u32x4 pack8(f32x4 a, f32x4 b) { u32x4 w; w.x = cvtpk(a[0], a[1]); w.y = cvtpk(a[2], a[3]); w.z = cvtpk(b[0], b[1]); w.w = cvtpk(b[2], b[3]); return w; }
__device__ __forceinline__ float ex2(float x) { return __builtin_amdgcn_exp2f(x); }
__device__ __forceinline__ float sigm(float x) { return __builtin_amdgcn_rcpf(1.f + ex2(-x * L2E)); }
__device__ __forceinline__ void l1_inv() { __builtin_amdgcn_fence(__ATOMIC_ACQUIRE, "agent"); }

struct NoLoad {};
template <class F> struct EpiF {
    static constexpr bool PERM = true, AFTER_DRAIN = false, CHAIN = false; static constexpr int MIDK = 0; F f;
    __device__ __forceinline__ void operator()(const f32x4 (&acc)[2][2][4][2], const pg8::Unit& u, int wr, int wc, int fr, int fq) const {
        const int row0 = u.pm * 256 + wr * 64 + fr, col0 = u.pn * 256 + wc * 32 + 8 * fq;
        f.begin();
        typename F::L cur0 = f.load(row0, col0), cur1 = f.load(row0, col0 + 128);
#pragma unroll
        for (int b = 0; b < 8; ++b) {
            const int row = row0 + (b >> 2) * 128 + (b & 3) * 16;
            typename F::L nxt0 = cur0, nxt1 = cur1;
            if (b + 1 < 8) { const int rn = row0 + ((b + 1) >> 2) * 128 + ((b + 1) & 3) * 16; nxt0 = f.load(rn, col0); nxt1 = f.load(rn, col0 + 128); }
            f.apply(row, col0, acc[b >> 2][0][b & 3][0], acc[b >> 2][0][b & 3][1], cur0);
            f.apply(row, col0 + 128, acc[b >> 2][1][b & 3][0], acc[b >> 2][1][b & 3][1], cur1);
            cur0 = nxt0; cur1 = nxt1;
        }
    }
};
struct FIn {
    struct L { f32x4 t0, t1; };
    GAS bf16_t* HA; GAS float* FL; GAS float* IW; const GAS float* cs;
    __device__ __forceinline__ void begin() const {}
    static __device__ __forceinline__ bool is_rope(int c0) { return (c0 >= 2112 && c0 < 2496) || (c0 >= 2560 && c0 < 3136); }
    __device__ __forceinline__ L load(int row, int c0) const {
        L l; l.t0 = (f32x4){1.f, 0.f, 1.f, 0.f}; l.t1 = l.t0;
        if (is_rope(c0)) { const int pos = row & (SEQ - 1), i0 = (c0 & 63) >> 1; const GAS float* tp = cs + ((size_t)pos * 32 + i0) * 2; l.t0 = *(const GAS f32x4*)tp; l.t1 = *(const GAS f32x4*)(tp + 4); }
        return l;
    }
    __device__ __forceinline__ void apply(int row, int c0, f32x4 v0, f32x4 v1, const L& l) const {
        if (c0 >= 3152) return;
        if (c0 >= 3136) { GAS float* d = (c0 == 3136 ? FL : IW) + (size_t)row * 8; *(GAS f32x4*)d = v0; *(GAS f32x4*)(d + 4) = v1; return; }
        if (is_rope(c0)) {
            const f32x4 t0 = l.t0, t1 = l.t1;
            float a, b;
            a = v0[0] * t0[0] - v0[1] * t0[1]; b = v0[1] * t0[0] + v0[0] * t0[1]; v0[0] = a; v0[1] = b;
            a = v0[2] * t0[2] - v0[3] * t0[3]; b = v0[3] * t0[2] + v0[2] * t0[3]; v0[2] = a; v0[3] = b;
            a = v1[0] * t1[0] - v1[1] * t1[1]; b = v1[1] * t1[0] + v1[0] * t1[1]; v1[0] = a; v1[1] = b;
            a = v1[2] * t1[2] - v1[3] * t1[3]; b = v1[3] * t1[2] + v1[2] * t1[3]; v1[2] = a; v1[3] = b;
        }
        const bool isq = (c0 < 384) || (c0 >= 1152 && c0 < 1472) || (c0 >= 2112 && c0 < 2432);
        if (isq) { v0 = v0 * (0.125f * L2E); v1 = v1 * (0.125f * L2E); }
        *(GAS u32x4*)(HA + (size_t)row * LDH + c0) = pack8(v0, v1);
    }
};
struct FGateT {
    typedef NoLoad L;
    GAS unsigned char* Gt; int ro, co;
    __device__ __forceinline__ void begin() const {}
    __device__ __forceinline__ L load(int, int) const { return L{}; }
    __device__ __forceinline__ void apply(int row, int c0, f32x4 v0, f32x4 v1, const L&) const {
        u32x2 w; w.x = 0u; w.y = 0u;
        w.x = __builtin_amdgcn_cvt_pk_u8_f32(sigm(v0[0]) * 255.f, 0, w.x); w.x = __builtin_amdgcn_cvt_pk_u8_f32(sigm(v0[1]) * 255.f, 1, w.x);
        w.x = __builtin_amdgcn_cvt_pk_u8_f32(sigm(v0[2]) * 255.f, 2, w.x); w.x = __builtin_amdgcn_cvt_pk_u8_f32(sigm(v0[3]) * 255.f, 3, w.x);
        w.y = __builtin_amdgcn_cvt_pk_u8_f32(sigm(v1[0]) * 255.f, 0, w.y); w.y = __builtin_amdgcn_cvt_pk_u8_f32(sigm(v1[1]) * 255.f, 1, w.y);
        w.y = __builtin_amdgcn_cvt_pk_u8_f32(sigm(v1[2]) * 255.f, 2, w.y); w.y = __builtin_amdgcn_cvt_pk_u8_f32(sigm(v1[3]) * 255.f, 3, w.y);
        *(GAS u32x2*)(Gt + (row - ro) * 256 + (c0 - co)) = w;
    }
};
struct FUpT {
    struct L { u32x2 g; u32x4 m; };
    const GAS unsigned char* Gt; GAS bf16_t* Mt; GAS bf16_t* MG; int ro, co, mode;
    __device__ __forceinline__ void begin() const { l1_inv(); }
    __device__ __forceinline__ L load(int row, int c0) const {
        const int o = (row - ro) * 256 + (c0 - co);
        L l; l.g = *(const GAS u32x2*)(Gt + o); l.m = (u32x4){0u, 0u, 0u, 0u};
        if (mode != 0) l.m = *(const GAS u32x4*)(Mt + o);
        return l;
    }
    __device__ __forceinline__ void apply(int row, int c0, f32x4 v0, f32x4 v1, const L& l) const {
        const int o = (row - ro) * 256 + (c0 - co);
        const float k = 1.f / 255.f; const u32x2 g = l.g; const u32x4 m = l.m;
        f32x4 r0, r1;
        r0[0] = bflo(m.x) + (float)((g.x >> 0) & 0xffu) * k * v0[0]; r0[1] = bfhi(m.x) + (float)((g.x >> 8) & 0xffu) * k * v0[1];
        r0[2] = bflo(m.y) + (float)((g.x >> 16) & 0xffu) * k * v0[2]; r0[3] = bfhi(m.y) + (float)((g.x >> 24) & 0xffu) * k * v0[3];
        r1[0] = bflo(m.z) + (float)((g.y >> 0) & 0xffu) * k * v1[0]; r1[1] = bfhi(m.z) + (float)((g.y >> 8) & 0xffu) * k * v1[1];
        r1[2] = bflo(m.w) + (float)((g.y >> 16) & 0xffu) * k * v1[2]; r1[3] = bfhi(m.w) + (float)((g.y >> 24) & 0xffu) * k * v1[3];
        if (mode != 2) *(GAS u32x4*)(Mt + o) = pack8(r0, r1);
        else *(GAS u32x4*)(MG + (size_t)row * DM + c0) = pack8(r0, r1);
    }
};
struct FGateT3 {
    typedef NoLoad L;
    GAS unsigned char* Gt; int ro, co;
    __device__ __forceinline__ void begin() const {}
    __device__ __forceinline__ L load(int, int) const { return L{}; }
    __device__ __forceinline__ void apply(int row, int c0, f32x4 v0, f32x4 v1, const L&) const {
        const int j = c0 >> 10;
        u32x2 w; w.x = 0u; w.y = 0u;
        w.x = __builtin_amdgcn_cvt_pk_u8_f32(sigm(v0[0]) * 255.f, 0, w.x); w.x = __builtin_amdgcn_cvt_pk_u8_f32(sigm(v0[1]) * 255.f, 1, w.x);
        w.x = __builtin_amdgcn_cvt_pk_u8_f32(sigm(v0[2]) * 255.f, 2, w.x); w.x = __builtin_amdgcn_cvt_pk_u8_f32(sigm(v0[3]) * 255.f, 3, w.x);
        w.y = __builtin_amdgcn_cvt_pk_u8_f32(sigm(v1[0]) * 255.f, 0, w.y); w.y = __builtin_amdgcn_cvt_pk_u8_f32(sigm(v1[1]) * 255.f, 1, w.y);
        w.y = __builtin_amdgcn_cvt_pk_u8_f32(sigm(v1[2]) * 255.f, 2, w.y); w.y = __builtin_amdgcn_cvt_pk_u8_f32(sigm(v1[3]) * 255.f, 3, w.y);
        *(GAS u32x2*)(Gt + j * 65536 + (row - ro) * 256 + ((c0 & 1023) - co)) = w;
    }
};
struct FUpT3 {
    struct L { u32x2 g; u32x4 m; };
    const GAS unsigned char* Gt; GAS bf16_t* Mt; GAS bf16_t* MG; int ro, co;
    __device__ __forceinline__ void begin() const { l1_inv(); }
    __device__ __forceinline__ L load(int row, int c0) const {
        const int j = c0 >> 10; const int o = (row - j * T_TOK - ro) * 256 + ((c0 & 1023) - co);
        L l; l.g = *(const GAS u32x2*)(Gt + j * 65536 + o); l.m = (u32x4){0u, 0u, 0u, 0u};
        if (j != 0) l.m = *(const GAS u32x4*)(Mt + o);
        return l;
    }
    __device__ __forceinline__ void apply(int row, int c0, f32x4 v0, f32x4 v1, const L& l) const {
        const int j = c0 >> 10; const int rr = row - j * T_TOK, cc = c0 & 1023; const int o = (rr - ro) * 256 + (cc - co);
        const float k = 1.f / 255.f; const u32x2 g = l.g; const u32x4 m = l.m;
        f32x4 r0, r1;
        r0[0] = bflo(m.x) + (float)((g.x >> 0) & 0xffu) * k * v0[0]; r0[1] = bfhi(m.x) + (float)((g.x >> 8) & 0xffu) * k * v0[1];
        r0[2] = bflo(m.y) + (float)((g.x >> 16) & 0xffu) * k * v0[2]; r0[3] = bfhi(m.y) + (float)((g.x >> 24) & 0xffu) * k * v0[3];
        r1[0] = bflo(m.z) + (float)((g.y >> 0) & 0xffu) * k * v1[0]; r1[1] = bfhi(m.z) + (float)((g.y >> 8) & 0xffu) * k * v1[1];
        r1[2] = bflo(m.w) + (float)((g.y >> 16) & 0xffu) * k * v1[2]; r1[3] = bfhi(m.w) + (float)((g.y >> 24) & 0xffu) * k * v1[3];
        if (j != 2) *(GAS u32x4*)(Mt + o) = pack8(r0, r1);
        else *(GAS u32x4*)(MG + (size_t)rr * DM + cc) = pack8(r0, r1);
    }
};
struct EpiUpChain {
    static constexpr bool PERM = true, AFTER_DRAIN = false, CHAIN = true; static constexpr int MIDK = 0;
    const GAS unsigned char* Gt; GAS bf16_t* MG; int ro, co;
    __device__ __forceinline__ void operator()(const f32x4 (&)[2][2][4][2], const pg8::Unit&, int, int, int, int) const {}
    static __device__ __forceinline__ float gb(unsigned w, int sh) { return (float)max((w >> sh) & 0xffu, 1u); }
    __device__ __forceinline__ void chain(f32x4 (&acc)[2][2][4][2], const pg8::Unit& u, bool has_next, int wr, int wc, int fr, int fq) const {
        const int j = u.pn >> 2;
        const GAS unsigned char* ga_p = Gt + j * 65536 + (wr * 64 + fr) * 256 + wc * 32 + 8 * fq;
        if (has_next) {
#pragma unroll
            for (int h2 = 0; h2 < 2; ++h2) {
                u32x2 ga[8], gn[8];
#pragma unroll
                for (int m = 0; m < 4; ++m)
#pragma unroll
                    for (int bj = 0; bj < 2; ++bj) { const int o = (h2 * 128 + m * 16) * 256 + bj * 128; ga[2 * m + bj] = *(const GAS u32x2*)(ga_p + o); gn[2 * m + bj] = *(const GAS u32x2*)(ga_p + 65536 + o); }
#pragma unroll
                for (int m = 0; m < 4; ++m)
#pragma unroll
                    for (int bj = 0; bj < 2; ++bj) {
                        const u32x2 a = ga[2 * m + bj], n = gn[2 * m + bj];
                        f32x4 v0 = acc[h2][bj][m][0], v1 = acc[h2][bj][m][1];
                        v0[0] *= gb(a.x, 0) * __builtin_amdgcn_rcpf(gb(n.x, 0)); v0[1] *= gb(a.x, 8) * __builtin_amdgcn_rcpf(gb(n.x, 8));
                        v0[2] *= gb(a.x, 16) * __builtin_amdgcn_rcpf(gb(n.x, 16)); v0[3] *= gb(a.x, 24) * __builtin_amdgcn_rcpf(gb(n.x, 24));
                        v1[0] *= gb(a.y, 0) * __builtin_amdgcn_rcpf(gb(n.y, 0)); v1[1] *= gb(a.y, 8) * __builtin_amdgcn_rcpf(gb(n.y, 8));
                        v1[2] *= gb(a.y, 16) * __builtin_amdgcn_rcpf(gb(n.y, 16)); v1[3] *= gb(a.y, 24) * __builtin_amdgcn_rcpf(gb(n.y, 24));
                        acc[h2][bj][m][0] = v0; acc[h2][bj][m][1] = v1;
                    }
            }
        } else {
#pragma unroll
            for (int h2 = 0; h2 < 2; ++h2) {
                u32x2 ga[8];
#pragma unroll
                for (int m = 0; m < 4; ++m)
#pragma unroll
                    for (int bj = 0; bj < 2; ++bj) ga[2 * m + bj] = *(const GAS u32x2*)(ga_p + (h2 * 128 + m * 16) * 256 + bj * 128);
#pragma unroll
                for (int m = 0; m < 4; ++m)
#pragma unroll
                    for (int bj = 0; bj < 2; ++bj) {
                        const u32x2 a = ga[2 * m + bj]; const float k = 1.f / 255.f;
                        f32x4 v0 = acc[h2][bj][m][0], v1 = acc[h2][bj][m][1];
                        v0[0] *= gb(a.x, 0) * k; v0[1] *= gb(a.x, 8) * k; v0[2] *= gb(a.x, 16) * k; v0[3] *= gb(a.x, 24) * k;
                        v1[0] *= gb(a.y, 0) * k; v1[1] *= gb(a.y, 8) * k; v1[2] *= gb(a.y, 16) * k; v1[3] *= gb(a.y, 24) * k;
                        const int row = ro + wr * 64 + fr + h2 * 128 + m * 16, col = co + wc * 32 + 8 * fq + bj * 128;
                        *(GAS u32x4*)(MG + (size_t)row * DM + col) = pack8(v0, v1);
                    }
            }
        }
    }
};
struct EpiFf2 {
    static constexpr bool PERM = true, AFTER_DRAIN = false, CHAIN = false; static constexpr int MIDK = 4;
    const GAS bf16_t* XB; GAS bf16_t* PG;
    __device__ __forceinline__ void mid(f32x4 (&acc)[2][2][4][2], const pg8::Unit& u, int wr, int wc, int fr, int fq) const {
        const size_t base = (size_t)(u.pm * 256 + wr * 64 + fr) * DM + u.pn * 256 + wc * 32 + 8 * fq;
#pragma unroll
        for (int b = 0; b < 8; b += 4) {
            u32x4 g[8], x[8];
#pragma unroll
            for (int i = 0; i < 8; ++i) { const int bb = b + (i >> 1), bj = i & 1; const size_t o = base + (size_t)((bb >> 2) * 128 + (bb & 3) * 16) * DM + bj * 128; g[i] = *(const GAS u32x4*)(PG + o); x[i] = *(const GAS u32x4*)(XB + o); }
#pragma unroll
            for (int i = 0; i < 8; ++i) {
                const int bb = b + (i >> 1), bj = i & 1; const u32x4 gg = g[i], xx = x[i];
                f32x4 v0 = acc[bb >> 2][bj][bb & 3][0], v1 = acc[bb >> 2][bj][bb & 3][1];
                v0[0] = v0[0] * bflo(gg.x) + ALPHA * bflo(xx.x); v0[1] = v0[1] * bfhi(gg.x) + ALPHA * bfhi(xx.x); v0[2] = v0[2] * bflo(gg.y) + ALPHA * bflo(xx.y); v0[3] = v0[3] * bfhi(gg.y) + ALPHA * bfhi(xx.y);
                v1[0] = v1[0] * bflo(gg.z) + ALPHA * bflo(xx.z); v1[1] = v1[1] * bfhi(gg.z) + ALPHA * bfhi(xx.z); v1[2] = v1[2] * bflo(gg.w) + ALPHA * bflo(xx.w); v1[3] = v1[3] * bfhi(gg.w) + ALPHA * bfhi(xx.w);
                acc[bb >> 2][bj][bb & 3][0] = v0; acc[bb >> 2][bj][bb & 3][1] = v1;
            }
        }
        asm volatile("s_waitcnt vmcnt(0)" ::: "memory");
    }
    __device__ __forceinline__ void operator()(const f32x4 (&acc)[2][2][4][2], const pg8::Unit& u, int wr, int wc, int fr, int fq) const {
        const size_t base = (size_t)(u.pm * 256 + wr * 64 + fr) * DM + u.pn * 256 + wc * 32 + 8 * fq;
#pragma unroll
        for (int b = 0; b < 8; ++b)
#pragma unroll
            for (int bj = 0; bj < 2; ++bj)
                *(GAS u32x4*)(PG + base + (size_t)((b >> 2) * 128 + (b & 3) * 16) * DM + bj * 128) = pack8(acc[b >> 2][bj][b & 3][0], acc[b >> 2][bj][b & 3][1]);
    }
};
struct TriUnit {
    int pm, pn, dpm;
    __device__ __forceinline__ bool next(int i, pg8::Unit& o) const { if (i >= 3) return false; o.pm = pm + i * dpm; o.pn = pn + 4 * i; return true; }
    __device__ __forceinline__ void a_ready(const pg8::Unit&) const {}
    __device__ __forceinline__ void done(const pg8::Unit&) const {}
};
struct OneUnit {
    pg8::Unit u;
    __device__ __forceinline__ bool next(int i, pg8::Unit& o) const { if (i != 0) return false; o = u; return true; }
    __device__ __forceinline__ void a_ready(const pg8::Unit&) const {}
    __device__ __forceinline__ void done(const pg8::Unit&) const {}
};
struct FOut {
    struct L { u32x4 g; f32x4 a, b; };
    const GAS float* res; const GAS bf16_t* resb; GAS bf16_t* dst;
    __device__ __forceinline__ void begin() const {}
    __device__ __forceinline__ L load(int row, int c0) const {
        const size_t o = (size_t)row * DM + c0; L l; l.g = (u32x4){0u, 0u, 0u, 0u}; l.a = (f32x4){0.f, 0.f, 0.f, 0.f}; l.b = l.a;
        if (res) { l.a = *(const GAS f32x4*)(res + o); l.b = *(const GAS f32x4*)(res + o + 4); } else l.g = *(const GAS u32x4*)(resb + o);
        return l;
    }
    __device__ __forceinline__ void apply(int row, int c0, f32x4 v0, f32x4 v1, const L& l) const {
        const size_t o = (size_t)row * DM + c0;
        f32x4 a = l.a, b = l.b;
        if (!res) { const u32x4 g = l.g; a = (f32x4){bflo(g.x), bfhi(g.x), bflo(g.y), bfhi(g.y)}; b = (f32x4){bflo(g.z), bfhi(g.z), bflo(g.w), bfhi(g.w)}; }
        *(GAS u32x4*)(dst + o) = pack8(a * ALPHA + v0, b * ALPHA + v1);
    }
};
struct FFf1 {
    typedef NoLoad L;
    GAS bf16_t* HF; GAS bf16_t* PG;
    __device__ __forceinline__ void begin() const {}
    __device__ __forceinline__ L load(int, int) const { return L{}; }
    __device__ __forceinline__ void apply(int row, int c0, f32x4 v0, f32x4 v1, const L&) const {
        if (c0 < DFF) {
#pragma unroll
            for (int i = 0; i < 4; ++i) { const float a = fmaxf(v0[i], 0.f), b = fmaxf(v1[i], 0.f); v0[i] = a * a; v1[i] = b * b; }
            *(GAS u32x4*)(HF + (size_t)row * HFP + 256 + c0) = pack8(v0, v1);
        } else {
#pragma unroll
            for (int i = 0; i < 4; ++i) { v0[i] = sigm(v0[i]); v1[i] = sigm(v1[i]); }
            *(GAS u32x4*)(PG + (size_t)row * DM + (c0 - DFF)) = pack8(v0, v1);
        }
    }
};
struct FPle {
    struct L { u32x4 g; };
    GAS bf16_t* PG;
    __device__ __forceinline__ void begin() const {}
    __device__ __forceinline__ L load(int row, int c0) const { L l; l.g = *(const GAS u32x4*)(PG + (size_t)row * DM + c0); return l; }
    __device__ __forceinline__ void apply(int row, int c0, f32x4 v0, f32x4 v1, const L& l) const {
        const size_t o = (size_t)row * DM + c0; const u32x4 g = l.g;
        v0[0] *= bflo(g.x); v0[1] *= bfhi(g.x); v0[2] *= bflo(g.y); v0[3] *= bfhi(g.y);
        v1[0] *= bflo(g.z); v1[1] *= bfhi(g.z); v1[2] *= bflo(g.w); v1[3] *= bfhi(g.w);
        *(GAS u32x4*)(PG + o) = pack8(v0, v1);
    }
};
struct FFf2 {
    struct L { u32x4 g, x; };
    const GAS bf16_t* XB; GAS bf16_t* PG;
    __device__ __forceinline__ void begin() const { l1_inv(); }
    __device__ __forceinline__ L load(int row, int c0) const { const size_t o = (size_t)row * DM + c0; L l; l.g = *(const GAS u32x4*)(PG + o); l.x = *(const GAS u32x4*)(XB + o); return l; }
    __device__ __forceinline__ void apply(int row, int c0, f32x4 v0, f32x4 v1, const L& l) const {
        const size_t o = (size_t)row * DM + c0;
        const u32x4 g = l.g, x = l.x;
        f32x4 r0 = v0, r1 = v1;
        r0[0] += bflo(g.x) + ALPHA * bflo(x.x); r0[1] += bfhi(g.x) + ALPHA * bfhi(x.x); r0[2] += bflo(g.y) + ALPHA * bflo(x.y); r0[3] += bfhi(g.y) + ALPHA * bfhi(x.y);
        r1[0] += bflo(g.z) + ALPHA * bflo(x.z); r1[1] += bfhi(g.z) + ALPHA * bfhi(x.z); r1[2] += bflo(g.w) + ALPHA * bflo(x.w); r1[3] += bfhi(g.w) + ALPHA * bfhi(x.w);
        *(GAS u32x4*)(PG + o) = pack8(r0, r1);
    }
};
template <class F> __device__ __forceinline__ void run_gemm(LAS unsigned char* lds, const bf16_t* A, const bf16_t* Bt, int M, int N, int K, const F& f) {
    asm volatile("" : "+s"(K), "+s"(N), "+s"(M));
    pg8::Gemm g{A, Bt, M, N, K}; pg8::StaticOrder S; S.init(M, N, (int)gridDim.x, (int)blockIdx.x);
    EpiF<F> E{f};
    pg8::gemm_phase<EpiF<F>, pg8::StaticOrder, true, true>(lds, g, S, E);
}
template <class F> __device__ __forceinline__ void run_gemm_one(LAS unsigned char* lds, const bf16_t* A, const bf16_t* Bt, int M, int N, int K, pg8::Unit u, const F& f) {
    asm volatile("" : "+s"(K), "+s"(N), "+s"(M));
    pg8::Gemm g{A, Bt, M, N, K}; OneUnit S{u};
    EpiF<F> E{f};
    pg8::gemm_phase<EpiF<F>, OneUnit, true, true>(lds, g, S, E);
}
template <class F> __device__ __forceinline__ void run_gemm_tri(LAS unsigned char* lds, const bf16_t* A, const bf16_t* Bt, int M, int N, int K, TriUnit S, const F& f) {
    asm volatile("" : "+s"(K), "+s"(N), "+s"(M));
    pg8::Gemm g{A, Bt, M, N, K};
    EpiF<F> E{f};
    pg8::gemm_phase<EpiF<F>, TriUnit, true, true>(lds, g, S, E);
}
__device__ __forceinline__ void run_gemm_ff2(LAS unsigned char* lds, const bf16_t* A, const bf16_t* Bt, int M, int N, int K, const EpiFf2& E) {
    asm volatile("" : "+s"(K), "+s"(N), "+s"(M));
    pg8::Gemm g{A, Bt, M, N, K}; pg8::StaticOrder S; S.init(M, N, (int)gridDim.x, (int)blockIdx.x);
    pg8::gemm_phase<EpiFf2, pg8::StaticOrder, true, true>(lds, g, S, E);
}
__device__ __forceinline__ void run_gemm_chain(LAS unsigned char* lds, const bf16_t* A, const bf16_t* Bt, int M, int N, int K, TriUnit S, const EpiUpChain& E) {
    asm volatile("" : "+s"(K), "+s"(N), "+s"(M));
    pg8::Gemm g{A, Bt, M, N, K};
    pg8::gemm_phase<EpiUpChain, TriUnit, true, true>(lds, g, S, E);
}
__device__ __forceinline__ int win_src(int n) {
    if (n < 1152) return n;
    if (n < 2112) { const int e = n - 1152; return 1158 + e; }
    if (n < 2432) { const int e = n - 2112, hh = e >> 6, p = e & 63; return 2118 + hh * 64 + (p >> 1) + 32 * (p & 1); }
    if (n < 2496) { const int p = n - 2432; return 2438 + (p >> 1) + 32 * (p & 1); }
    if (n < 2560) return 2502 + (n - 2496);
    if (n < 3072) { const int e = n - 2560, hh = e >> 6, p = e & 63; return 2566 + hh * 64 + (p >> 1) + 32 * (p & 1); }
    if (n < 3136) { const int p = n - 3072; return 3078 + (p >> 1) + 32 * (p & 1); }
    if (n < 3142) return 1152 + (n - 3136);
    if (n < 3144) return -1;
    if (n < 3152) return 3142 + (n - 3144);
    return -1;
}
struct GWin { const float* W; __device__ __forceinline__ float operator()(int k, int n) const { const int s = win_src(n); return s < 0 ? 0.f : W[(size_t)k * CIN + s]; } };
struct GWg { const float* W; int j; __device__ __forceinline__ float operator()(int k, int n) const { return W[(size_t)k * CIN + 3150 + j * DM + n]; } };
struct GUp { const float* W; int kj; __device__ __forceinline__ float operator()(int k, int n) const { return k < kj ? W[(size_t)k * DM + n] : 0.f; } };
struct GPlain { const float* W; int pitch; __device__ __forceinline__ float operator()(int k, int n) const { return W[(size_t)k * pitch + n]; } };
struct GCat { const float* Wp; const float* Wf; __device__ __forceinline__ float operator()(int k, int n) const { return k < 256 ? Wp[(size_t)k * DM + n] : Wf[(size_t)(k - 256) * DM + n]; } };
struct GFf1 { const float* Wf; const float* Wp; __device__ __forceinline__ float operator()(int k, int n) const { return n < DFF ? Wf[(size_t)k * DFF + n] : Wp[(size_t)k * DM + (n - DFF)]; } };
template <class G> __device__ __forceinline__ void tr_item(const G& get, int K, int N, bf16_t* WT, LAS float* scr, int item, int lane) {
    const int nblk = N / 32, kb = item / nblk, nb = item % nblk, k0 = 64 * kb, n0 = 32 * nb;
#pragma unroll 8
    for (int i = 0; i < 32; ++i) { const int kk = 2 * i + (lane >> 5); scr[kk * 33 + (lane & 31)] = get(k0 + kk, n0 + (lane & 31)); }
    asm volatile("s_waitcnt lgkmcnt(0)" ::: "memory");
    const int c = lane & 7;
#pragma unroll
    for (int j = 0; j < 4; ++j) { const int n = (lane >> 3) + 8 * j; const LAS float* s = scr + (8 * c) * 33 + n;
        u32x4 o; o.x = cvtpk(s[0 * 33], s[1 * 33]); o.y = cvtpk(s[2 * 33], s[3 * 33]); o.z = cvtpk(s[4 * 33], s[5 * 33]); o.w = cvtpk(s[6 * 33], s[7 * 33]);
        *(u32x4*)(WT + (size_t)(n0 + n) * K + k0 + 8 * c) = o; }
    asm volatile("s_waitcnt lgkmcnt(0)" ::: "memory");
}
__device__ __forceinline__ void sincos_d(double x, double& s, double& c) {
    const double k = rint(x * 0.63661977236758134308);
    const double r = fma(-k, 6.123233995736766e-17, fma(-k, 1.5707963267948966, x));
    const double r2 = r * r;
    const double sp = r * (1.0 + r2 * (-1.0 / 6 + r2 * (1.0 / 120 + r2 * (-1.0 / 5040 + r2 * (1.0 / 362880 + r2 * (-1.0 / 39916800 + r2 * (1.0 / 6227020800.0)))))));
    const double cp = 1.0 + r2 * (-0.5 + r2 * (1.0 / 24 + r2 * (-1.0 / 720 + r2 * (1.0 / 40320 + r2 * (-1.0 / 3628800 + r2 * (1.0 / 479001600 + r2 * (-1.0 / 87178291200.0)))))));
    const int q = ((int)k) & 3;
    s = (q == 0) ? sp : (q == 1) ? cp : (q == 2) ? -sp : -cp;
    c = (q == 0) ? cp : (q == 1) ? -sp : (q == 2) ? -cp : sp;
}
struct Args { const float* in[16]; float* out; unsigned char* ws; };

__device__ __forceinline__ void prologue(LAS unsigned char* lds, const Args& a) {
    const int tid = opaque_tid(), lane = tid & 63, wid = __builtin_amdgcn_readfirstlane(tid >> 6);
    LAS float* scr = (LAS float*)(lds + wid * 16384);
    const int gw = blockIdx.x * 8 + wid, NGW = gridDim.x * 8;
    unsigned char* ws = a.ws;
    constexpr int I_IN = 16 * (NIN / 32), I_G = 3 * 512, I_UP = 3 * 192, I_OUT = 512, I_FF1 = 16 * (NFF1 / 32), I_FF2 = (HFP / 64) * 32, I_PLE = 0;
    constexpr int I_LAYER = I_IN + I_G + I_UP + I_OUT + I_FF1 + I_FF2 + I_PLE;
    for (int it = gw; it < 2 * I_LAYER; it += NGW) {
        const int L = it / I_LAYER; int r = it % I_LAYER;
        unsigned char* wl = ws + WS_W + (size_t)L * W_LAYER;
        if (r < I_IN) { tr_item(GWin{a.in[2] + (size_t)L * DM * CIN}, DM, NIN, (bf16_t*)(wl + WO_IN), scr, r, lane); continue; } r -= I_IN;
        if (r < I_G) { const int j = r / 512; tr_item(GWg{a.in[2] + (size_t)L * DM * CIN, j}, DM, DM, (bf16_t*)(wl + WO_G) + (size_t)j * DM * DM, scr, r % 512, lane); continue; } r -= I_G;
        if (r < I_UP) { const int j = r / 192; const int kj = j == 0 ? 384 : 320; const float* src = a.in[4 + j] + (size_t)L * kj * DM;
            tr_item(GUp{src, kj}, OCW, DM, (bf16_t*)(wl + WO_UP) + (size_t)j * DM * OCW, scr, r % 192, lane); continue; } r -= I_UP;
        if (r < I_OUT) { tr_item(GPlain{a.in[7] + (size_t)L * DM * DM, DM}, DM, DM, (bf16_t*)(wl + WO_OUT), scr, r, lane); continue; } r -= I_OUT;
        if (r < I_FF1) { tr_item(GFf1{a.in[10] + (size_t)L * DM * DFF, a.in[13] + (size_t)L * DM * DM}, DM, NFF1, (bf16_t*)(wl + WO_FF1), scr, r, lane); continue; } r -= I_FF1;
        tr_item(GCat{a.in[12] + (size_t)L * 256 * DM, a.in[11] + (size_t)L * DFF * DM}, HFP, DM, (bf16_t*)(wl + WO_FF2), scr, r, lane);
    }
    const size_t gt = (size_t)blockIdx.x * 512 + tid, NT = (size_t)gridDim.x * 512;
    {
        const f32x4* x4 = (const f32x4*)a.in[0]; u32x4* xb = (u32x4*)(ws + WS_XB);
        for (size_t i = gt; i < (size_t)T_TOK * DM / 8; i += NT) xb[i] = pack8(x4[2 * i], x4[2 * i + 1]);
        const f32x4* p4 = (const f32x4*)a.in[1]; u32x4* pb = (u32x4*)(ws + WS_PB);
        for (size_t i = gt; i < (size_t)2 * T_TOK * 256 / 8; i += NT) pb[i] = pack8(p4[2 * i], p4[2 * i + 1]);
    }
    {
        bf16_t* oc = (bf16_t*)(ws + WS_OC);
        for (size_t i = gt; i < (size_t)2 * T_TOK * 8; i += NT) { const size_t j = i / ((size_t)T_TOK * 8), rr = i % ((size_t)T_TOK * 8), row = rr >> 3, ch = rr & 7;
            *(u32x4*)(oc + (1 + j) * OC_STRIDE + row * OCW + 320 + ch * 8) = (u32x4){0u, 0u, 0u, 0u}; }
    }
    {
        float* cs = (float*)(ws + WS_TRIG);
        for (size_t e = gt; e < (size_t)SEQ * 32; e += NT) { const int pos = (int)(e >> 5), i = (int)(e & 31);
            double inv = 1.0; for (int t = 0; t < i; ++t) inv *= 0.7498942093324559;
            const float ang = (float)pos * (float)inv; double s, c; sincos_d((double)ang, s, c);
            cs[2 * e] = (float)c; cs[2 * e + 1] = (float)s; }
    }
}

__device__ __forceinline__ int next_unit(unsigned* ctr, LAS unsigned* slot) {
    __syncthreads();
    if (opaque_tid() == 0) *slot = atomicAdd(ctr, 1u);
    __syncthreads();
    return __builtin_amdgcn_readfirstlane((int)*slot);
}
__device__ __forceinline__ bf16x8 packf8(const f32x16& x, int s) {
    u32x4 w; w.x = cvtpk(x[8 * s], x[8 * s + 1]); w.y = cvtpk(x[8 * s + 2], x[8 * s + 3]); w.z = cvtpk(x[8 * s + 4], x[8 * s + 5]); w.w = cvtpk(x[8 * s + 6], x[8 * s + 7]);
    return __builtin_bit_cast(bf16x8, w);
}
template <int MODE>
__device__ __forceinline__ void attn_unit(LAS unsigned char* lds, const GAS bf16_t* __restrict__ HA, int b, int qb, int qcol, int kcol, int vcol,
                                          GAS bf16_t* __restrict__ O, int ocol, const GAS float* __restrict__ FL, float bfv, const GAS unsigned long long* __restrict__ MB) {
    const int tid = opaque_tid(), lane = tid & 63, r32 = lane & 31, hi = lane >> 5; const int wid = __builtin_amdgcn_readfirstlane(tid >> 6);
    LAS float* cbuf = (LAS float*)(lds + 36864); LAS float* wt = (LAS float*)(lds + 45056); LAS unsigned* flags = (LAS unsigned*)(lds + (MODE == 1 ? 92160 + 64 : 45088));
    const size_t rowbase = (size_t)b * SEQ; const int qw = qb * 256 + wid * 32, q = qw + r32; const int ntiles = 4 * (qb + 1), td = qw >> 6;
    float cq = 0.f;
    if (MODE == 0) {
        float lf[4];
#pragma unroll
        for (int i = 0; i < 4; ++i) { const float x = FL[(rowbase + 4 * tid + i) * 8] + bfv; lf[i] = (fminf(x, 0.f) - __logf(1.f + __expf(-fabsf(x)))) * L2E; }
        const float s1 = lf[0], s2 = s1 + lf[1], s3 = s2 + lf[2], s4 = s3 + lf[3];
        float v = s4;
#pragma unroll
        for (int off = 1; off < 64; off <<= 1) { const float n = __shfl_up(v, off); if (lane >= off) v += n; }
        if (lane == 63) wt[wid] = v;
        __syncthreads();
        float base = 0.f;
#pragma unroll
        for (int w = 0; w < 8; ++w) { const float x = wt[w]; if (w < wid) base += x; }
        const float ex = base + v - s4;
        *(LAS f32x4*)(cbuf + 4 * tid) = (f32x4){ex + s1, ex + s2, ex + s3, ex + s4};
        __syncthreads();
        cq = cbuf[q];
    }
    if (MODE == 1) { if (tid < 8) flags[tid] = 0u; }
    bf16x8 qr[4];
    { const GAS bf16_t* qp = HA + (rowbase + q) * LDH + qcol + hi * 8;
#pragma unroll
      for (int d0 = 0; d0 < 4; ++d0) qr[d0] = *(const GAS bf16x8*)(qp + d0 * 16); }
    bf16x8 T0, T1, ONES;
    if (MODE == 1) {
#pragma unroll
        for (int j = 0; j < 8; ++j) { const int kk = 8 * (j >> 2) + 4 * hi + (j & 3); T0[j] = (kk > r32) ? (short)0x3F80 : (short)0; T1[j] = (16 + kk > r32) ? (short)0x3F80 : (short)0; ONES[j] = (short)0x3F80; }
    }
    LAS unsigned long long* mlds = (LAS unsigned long long*)(lds + 45568) + (wid * 32 + r32) * 33;
    if (MODE == 2) {
        const GAS unsigned long long* mbp = MB + (rowbase + q) * 32 + hi * 16;
        u32x4 mw[8];
#pragma unroll
        for (int i = 0; i < 8; ++i) mw[i] = *(const GAS u32x4*)(mbp + 2 * i);
#pragma unroll
        for (int i = 0; i < 8; ++i) { mlds[hi * 16 + 2 * i] = ((unsigned long long)mw[i].y << 32) | mw[i].x; mlds[hi * 16 + 2 * i + 1] = ((unsigned long long)mw[i].w << 32) | mw[i].z; }
    }
    f32x16 zero16;
#pragma unroll
    for (int i = 0; i < 16; ++i) zero16[i] = 0.f;
    f32x16 o0 = zero16, o1 = zero16;
    float m = 0.f, l = 0.f, R = 0.f; bool uns = true;
    const int skr = tid >> 3, sch = tid & 7;
    const GAS bf16_t* kg = HA + (rowbase + skr) * LDH + kcol + sch * 8;
    const GAS bf16_t* vg = HA + (rowbase + skr) * LDH + vcol + sch * 8;
    const int t_first = (MODE == 1) ? ntiles - 1 : 0;
    u32x4 kreg = *(const GAS u32x4*)(kg + (size_t)t_first * 64 * LDH), vreg = *(const GAS u32x4*)(vg + (size_t)t_first * 64 * LDH);
#define STAGE_TILE(bufi, KR, VR) do { LAS bf16_t* Ks_ = (LAS bf16_t*)(lds + (bufi) * 18432); LAS bf16_t* Vs_ = (LAS bf16_t*)(lds + (bufi) * 18432 + 9216); \
        *(LAS u32x4*)(Ks_ + skr * 72 + sch * 8) = KR; *(LAS u32x4*)(Vs_ + skr * 72 + sch * 8) = VR; } while (0)
#define VTR(p) __builtin_bit_cast(s16x4, __builtin_amdgcn_ds_read_tr16_b64_v4i16((LAS v4i16_t*)(p)))
#define VFRAG(dblk, kb) __builtin_shufflevector(VTR(vp + 16 * (kb) * 72 + 32 * (dblk)), VTR(vp + (16 * (kb) + 8) * 72 + 32 * (dblk)), 0, 1, 2, 3, 4, 5, 6, 7)
#define COMPUTE_TILE(T_, CUR_) do { const int t = (T_); const int cur = (CUR_); \
        if (t <= td) { \
            const LAS bf16_t* Ks = (const LAS bf16_t*)(lds + cur * 18432); const LAS bf16_t* Vt = (const LAS bf16_t*)(lds + cur * 18432 + 9216); \
            unsigned long long bits = 0ull; \
            if (MODE == 2) bits = mlds[t]; \
            const float init = (MODE == 1) ? 0.f : cq - m; \
            const int kbase = t * 64 + 4 * hi; \
            f32x16 p0, p1; \
            if (MODE == 0) { \
_Pragma("unroll") \
                for (int g = 0; g < 4; ++g) { \
                    const f32x4 c0 = *(const LAS f32x4*)(cbuf + kbase + 8 * g), c1 = *(const LAS f32x4*)(cbuf + kbase + 32 + 8 * g); \
_Pragma("unroll") \
                    for (int i = 0; i < 4; ++i) { p0[4 * g + i] = init - c0[i]; p1[4 * g + i] = init - c1[i]; } \
                } \
            } else if (MODE == 2) { \
                const unsigned blo = (unsigned)(bits >> (4 * hi)), bhi = (unsigned)(bits >> (32 + 4 * hi)); \
_Pragma("unroll") \
                for (int r = 0; r < 16; ++r) { const int ix = (r & 3) + 8 * (r >> 2); p0[r] = ((blo >> ix) & 1u) ? init : NEGF; p1[r] = ((bhi >> ix) & 1u) ? init : NEGF; } \
            } else { \
_Pragma("unroll") \
                for (int r = 0; r < 16; ++r) { p0[r] = 0.f; p1[r] = 0.f; } \
            } \
            { const LAS bf16_t* kp = Ks + r32 * 72 + hi * 8; \
_Pragma("unroll") \
              for (int d0 = 0; d0 < 4; ++d0) { \
                  const bf16x8 k0 = *(const LAS bf16x8*)(kp + d0 * 16), k1 = *(const LAS bf16x8*)(kp + 32 * 72 + d0 * 16); \
                  p0 = MFMA32(k0, qr[d0], p0); p1 = MFMA32(k1, qr[d0], p1); \
              } } \
            if (MODE == 1) { \
                f32x16 lb0, lb1; \
_Pragma("unroll") \
                for (int r = 0; r < 16; ++r) { \
                    const int k = kbase + (r & 3) + 8 * (r >> 2); \
                    { const float z = p0[r], sp = fmaxf(z, 0.f) + __builtin_amdgcn_logf(1.f + ex2(-fabsf(z))); float L = -sp, lb = z - sp; if (t == td && k >= q) { L = 0.f; lb = NEGF; } p0[r] = L; lb0[r] = lb; } \
                    { const float z = p1[r], sp = fmaxf(z, 0.f) + __builtin_amdgcn_logf(1.f + ex2(-fabsf(z))); float L = -sp, lb = z - sp; if (t == td && k + 32 >= q) { L = 0.f; lb = NEGF; } p1[r] = L; lb1[r] = lb; } \
                } \
                const bf16x8 L00 = packf8(p0, 0), L01 = packf8(p0, 1), L10 = packf8(p1, 0), L11 = packf8(p1, 1); \
                const f32x16 X1 = MFMA32(ONES, L10, MFMA32(ONES, L11, zero16)); \
                const f32x16 a0 = MFMA32(T0, L00, MFMA32(T1, L01, X1)); \
                const f32x16 a1 = MFMA32(T0, L10, MFMA32(T1, L11, zero16)); \
                const f32x16 tt = MFMA32(ONES, L00, MFMA32(ONES, L01, X1)); \
_Pragma("unroll") \
                for (int r = 0; r < 16; ++r) { p0[r] = ex2(lb0[r] + a0[r] + R); p1[r] = ex2(lb1[r] + a1[r] + R); } \
                R += tt[0]; \
            } else { \
                float mx = NEGF; \
                if (MODE == 0 && t == td) { \
_Pragma("unroll") \
                    for (int r = 0; r < 16; ++r) { const int k = kbase + (r & 3) + 8 * (r >> 2); if (k > q) p0[r] = NEGF; if (k + 32 > q) p1[r] = NEGF; } \
                } \
_Pragma("unroll") \
                for (int r = 0; r < 16; ++r) mx = fmaxf(mx, fmaxf(p0[r], p1[r])); \
                mx = fmaxf(mx, __shfl_xor(mx, 32)); \
 \
                float dl = 0.f, f = 1.f; \
                if (uns) { if (mx > -1e29f) { dl = mx; uns = false; } } \
                else if (mx > 8.f) { dl = mx; f = ex2(-dl); } \
                if (__any(dl != 0.f)) { \
                    m += dl; l *= f; \
_Pragma("unroll") \
                    for (int r = 0; r < 16; ++r) { o0[r] *= f; o1[r] *= f; p0[r] -= dl; p1[r] -= dl; } \
                } \
                float ps = 0.f; \
_Pragma("unroll") \
                for (int r = 0; r < 16; ++r) { p0[r] = ex2(p0[r]); p1[r] = ex2(p1[r]); ps += p0[r] + p1[r]; } \
                l += ps; \
            } \
 \
            const bf16x8 pb0 = packf8(p0, 0), pb1 = packf8(p0, 1), pb2 = packf8(p1, 0), pb3 = packf8(p1, 1); \
 \
            const LAS bf16_t* vp = Vt + (4 * hi + ((lane & 15) >> 2)) * 72 + 16 * ((lane >> 4) & 1) + 4 * (lane & 3); \
            o0 = MFMA32(VFRAG(0, 0), pb0, o0); o0 = MFMA32(VFRAG(0, 1), pb1, o0); o0 = MFMA32(VFRAG(0, 2), pb2, o0); o0 = MFMA32(VFRAG(0, 3), pb3, o0); \
            o1 = MFMA32(VFRAG(1, 0), pb0, o1); o1 = MFMA32(VFRAG(1, 1), pb1, o1); o1 = MFMA32(VFRAG(1, 2), pb2, o1); o1 = MFMA32(VFRAG(1, 3), pb3, o1); \
            if (MODE == 1) { if (__all(R < -160.f) && lane == 0) flags[wid] = 1u; } \
        } \
    } while (0)
#define LOAD_TILE(KR, VR, tl) do { KR = *(const GAS u32x4*)(kg + (size_t)(tl) * 64 * LDH); VR = *(const GAS u32x4*)(vg + (size_t)(tl) * 64 * LDH); } while (0)
#define TILE_OF(it_) ((MODE == 1) ? ntiles - 1 - (it_) : (it_))
    if (MODE == 1) {
        u32x4 k1, v1, k2, v2, k3, v3;
        LOAD_TILE(k1, v1, ntiles - 2); LOAD_TILE(k2, v2, ntiles - 3); LOAD_TILE(k3, v3, ntiles - 4);
        STAGE_TILE((ntiles - 1) % 5, kreg, vreg); STAGE_TILE((ntiles - 2) % 5, k1, v1); STAGE_TILE((ntiles - 3) % 5, k2, v2); STAGE_TILE((ntiles - 4) % 5, k3, v3);
        __syncthreads();
        for (int i = 0; i < ntiles; ++i) {
            const int tnew = ntiles - 5 - i;
            if (tnew >= 0) LOAD_TILE(kreg, vreg, tnew);
            const int tw = td - i;
            if (tw >= 0) COMPUTE_TILE(tw, tw % 5);
            if (tnew >= 0) STAGE_TILE(tnew % 5, kreg, vreg);
            __syncthreads();
            { const u32x4 fa = *(const LAS u32x4*)flags, fb = *(const LAS u32x4*)(flags + 4); if ((fa.x & fa.y & fa.z & fa.w & fb.x & fb.y & fb.z & fb.w) != 0u) break; }
        }
    } else {
    u32x4 kB, vB;
    STAGE_TILE(0, kreg, vreg);
    LOAD_TILE(kB, vB, TILE_OF(1));
    __syncthreads();
    bool stop = false;
    for (int it = 0; it < ntiles && !stop; it += 2) {
        LOAD_TILE(kreg, vreg, TILE_OF(min(it + 2, ntiles - 1)));
        COMPUTE_TILE(TILE_OF(it), 0);
        STAGE_TILE(1, kB, vB);
        __syncthreads();
        if (MODE == 1) { const u32x4 fa = *(const LAS u32x4*)flags, fb = *(const LAS u32x4*)(flags + 4); if ((fa.x & fa.y & fa.z & fa.w & fb.x & fb.y & fb.z & fb.w) != 0u) break; }
        LOAD_TILE(kB, vB, TILE_OF(min(it + 3, ntiles - 1)));
        COMPUTE_TILE(TILE_OF(it + 1), 1);
        STAGE_TILE(0, kreg, vreg);
        __syncthreads();
        if (MODE == 1) { const u32x4 fa = *(const LAS u32x4*)flags, fb = *(const LAS u32x4*)(flags + 4); if ((fa.x & fa.y & fa.z & fa.w & fb.x & fb.y & fb.z & fb.w) != 0u) stop = true; }
    }
    }
#undef LOAD_TILE
#undef TILE_OF
#undef COMPUTE_TILE
#undef VTR
#undef VFRAG
#undef STAGE_TILE
    float inv = 1.f;
    if (MODE != 1) { const float lt = l + __shfl_xor(l, 32); inv = 1.f / lt; }
    GAS bf16_t* op = O + (rowbase + q) * OCW + ocol + 4 * hi;
#pragma unroll
    for (int g = 0; g < 4; ++g) {
        u32x2 w0, w1;
        w0.x = cvtpk(o0[4 * g] * inv, o0[4 * g + 1] * inv); w0.y = cvtpk(o0[4 * g + 2] * inv, o0[4 * g + 3] * inv);
        w1.x = cvtpk(o1[4 * g] * inv, o1[4 * g + 1] * inv); w1.y = cvtpk(o1[4 * g + 2] * inv, o1[4 * g + 3] * inv);
        *(GAS u32x2*)(op + 8 * g) = w0; *(GAS u32x2*)(op + 32 + 8 * g) = w1;
    }
}

__device__ __forceinline__ unsigned skey_of(float f) { const unsigned u = __float_as_uint(f); return u ^ ((unsigned)((int)u >> 31) | 0x80000000u); }
template <int NJ>
__device__ __forceinline__ void select_rows(const GAS float* sr0, GAS unsigned long long* mb0, LAS unsigned* hist, LAS unsigned* kbuf, int ntl, int lane) {
    unsigned vm = ntl >= 32 ? 0xffffffffu : ((1u << ntl) - 1u);
    asm volatile("" : "+v"(vm));
#pragma unroll 1
    for (int rr = 0; rr < 8; ++rr) {
        const GAS float* srow = sr0 + (size_t)rr * SEQ;
        float fv[NJ];
#pragma unroll
        for (int j = 0; j < NJ; ++j) fv[j] = srow[64 * j];
        { unsigned z = 0u; asm volatile("" : "+v"(z));
          *(LAS u32x4*)(hist + 4 * lane) = (u32x4){z, z, z, z}; if (lane < 2) hist[256 + lane] = z; }
        __builtin_amdgcn_wave_barrier();
        unsigned key[NJ];
#pragma unroll
        for (int j = 0; j < NJ; ++j) {
            const float f = fv[j]; const bool ok = (vm >> j) & 1u;
            key[j] = ok ? skey_of(f) : 0u;
            const int bk = min(max((int)floorf(f + f) + 128, 0), 255);
            __hip_atomic_fetch_add(hist + (ok ? bk : 256), 1u, __ATOMIC_RELAXED, __HIP_MEMORY_SCOPE_WORKGROUP);
        }
        __builtin_amdgcn_wave_barrier();
        asm volatile("s_waitcnt lgkmcnt(0)" ::: "memory");
        unsigned B, rem, C;
        {
            const u32x4 hv = *(const LAS u32x4*)(hist + 4 * lane);
            const unsigned s4 = hv.x + hv.y + hv.z + hv.w;
            unsigned S = s4;
#pragma unroll
            for (int off = 1; off < 64; off <<= 1) { const unsigned n = __shfl_down(S, off); if (lane + off < 64) S += n; }
            const unsigned excl = S - s4;
            const bool mine = (excl < 256u) && (256u <= S);
            unsigned dl, above, cnt, c = excl;
            if (c + hv.w >= 256u) { dl = 3; above = c; cnt = hv.w; } else { c += hv.w; if (c + hv.z >= 256u) { dl = 2; above = c; cnt = hv.z; } else { c += hv.z; if (c + hv.y >= 256u) { dl = 1; above = c; cnt = hv.y; } else { c += hv.y; dl = 0; above = c; cnt = hv.x; } } }
            const unsigned long long bm = __ballot(mine);
            const int src = bm ? (int)__builtin_ctzll(bm) : 0;
            B = (unsigned)__builtin_amdgcn_readlane((int)(4 * lane + dl), src);
            rem = 256u - (unsigned)__builtin_amdgcn_readlane((int)above, src);
            C = (unsigned)__builtin_amdgcn_readlane((int)cnt, src);
        }
        const unsigned klo = (B == 0u) ? 1u : skey_of((float)((int)B - 128) * 0.5f);
        const unsigned khi = (B == 255u) ? 0xffffffffu : skey_of((float)((int)B - 127) * 0.5f);
        const unsigned range = khi - klo;
        unsigned tau = 0u, remf = 0u, cnteq = 0u; bool generic = C > 64u;
        if (!generic) {
#pragma unroll
            for (int j = 0; j < NJ; ++j) {
                if ((key[j] - klo) < range) { const unsigned slot = __hip_atomic_fetch_add(hist + 257, 1u, __ATOMIC_RELAXED, __HIP_MEMORY_SCOPE_WORKGROUP); hist[258 + (slot & 63u)] = key[j]; }
            }
            __builtin_amdgcn_wave_barrier();
            asm volatile("s_waitcnt lgkmcnt(0)" ::: "memory");
            const bool have = (unsigned)lane < C;
            const unsigned mykey = have ? hist[258 + lane] : 0u;
            unsigned cgt = 0u;
            for (unsigned i = 0; i < C; ++i) { const unsigned o = (unsigned)__builtin_amdgcn_readlane((int)mykey, (int)i); cgt += (o > mykey) ? 1u : 0u; }
            unsigned t = (have && cgt < rem) ? mykey : 0xffffffffu;
#pragma unroll
            for (int o = 1; o < 64; o <<= 1) t = min(t, (unsigned)__shfl_xor((int)t, o));
            tau = t;
            const unsigned long long eqm = __ballot(have && mykey == tau);
            cnteq = (unsigned)__popcll(eqm);
            remf = rem - (unsigned)__builtin_amdgcn_readlane((int)cgt, eqm ? (int)__builtin_ctzll(eqm) : 0);
            generic = cnteq > remf;
        }
        unsigned mlo = 0u, mhi = 0u;
        if (!generic) {
#define WL1(J) if constexpr (J < NJ) { const unsigned long long w_ = __ballot(key[J] >= tau); const unsigned wl_ = (unsigned)w_, wh_ = (unsigned)(w_ >> 32); \
                asm volatile("s_nop 3\n\tv_writelane_b32 %0, %2, " #J "\n\tv_writelane_b32 %1, %3, " #J : "+v"(mlo), "+v"(mhi) : "s"(wl_), "s"(wh_)); }
            WL1(0) WL1(1) WL1(2) WL1(3) WL1(4) WL1(5) WL1(6) WL1(7) WL1(8) WL1(9) WL1(10) WL1(11) WL1(12) WL1(13) WL1(14) WL1(15)
            WL1(16) WL1(17) WL1(18) WL1(19) WL1(20) WL1(21) WL1(22) WL1(23) WL1(24) WL1(25) WL1(26) WL1(27) WL1(28) WL1(29) WL1(30) WL1(31)
#undef WL1
        } else {
#pragma unroll
            for (int j = 0; j < NJ; ++j) kbuf[64 * j + lane] = key[j];
            __builtin_amdgcn_wave_barrier();
            asm volatile("s_waitcnt lgkmcnt(0)" ::: "memory");
            unsigned pre = 0u;
            for (int bit = 31; bit >= 0; --bit) {
                const unsigned trial = pre | (1u << bit); unsigned cnt = 0u;
                for (int j = 0; j < NJ; ++j) cnt += (unsigned)__popcll(__ballot(kbuf[64 * j + lane] >= trial));
                if (cnt >= 256u) pre = trial;
            }
            unsigned cg = 0u;
            for (int j = 0; j < NJ; ++j) cg += (unsigned)__popcll(__ballot(kbuf[64 * j + lane] > pre));
            const unsigned take = 256u - cg; unsigned running = 0u;
            const unsigned long long lt_mask = (1ull << lane) - 1ull;
            for (int j = 0; j < NJ; ++j) {
                const unsigned k = kbuf[64 * j + lane];
                const bool eq = k == pre; const unsigned long long eqb = __ballot(eq);
                const unsigned before = running + (unsigned)__popcll(eqb & lt_mask);
                const unsigned long long w = __ballot(k > pre || (eq && before < take));
                running += (unsigned)__popcll(eqb);
                if (lane == j) { mlo = (unsigned)w; mhi = (unsigned)(w >> 32); }
            }
            __builtin_amdgcn_wave_barrier();
        }
        if (lane < 32) mb0[rr * 32 + lane] = ((unsigned long long)mhi << 32) | mlo;
    }
}

__device__ __forceinline__ unsigned sortable(float f) { unsigned u = __float_as_uint(f); if (u == 0x80000000u) u = 0u; return (u & 0x80000000u) ? ~u : (u | 0x80000000u); }
__device__ __forceinline__ void select_unit(LAS unsigned char* lds, const GAS bf16_t* __restrict__ HA, const GAS float* __restrict__ IW, int b, int qc, GAS float* __restrict__ scr, GAS unsigned long long* __restrict__ MB) {
    const int tid = opaque_tid(), lane = tid & 63, r32 = lane & 31, hi = lane >> 5; const int wid = __builtin_amdgcn_readfirstlane(tid >> 6);
    const size_t rowbase = (size_t)b * SEQ; const int ntl = qc + 1;
    if (ntl > 4) {
        const int c16 = lane & 15, lg = lane >> 4;
        const int ql = 16 * (wid & 3) + c16; const size_t qrow = rowbase + qc * 64 + ql;
        bf16x8 iqf[8][2]; float iwv[8];
        { const GAS bf16_t* qp = HA + qrow * LDH + 2560 + lg * 8;
#pragma unroll
          for (int hh = 0; hh < 8; ++hh) { iqf[hh][0] = *(const GAS bf16x8*)(qp + hh * 64); iqf[hh][1] = *(const GAS bf16x8*)(qp + hh * 64 + 32); }
          const f32x4 w0 = *(const GAS f32x4*)(IW + qrow * 8), w1 = *(const GAS f32x4*)(IW + qrow * 8 + 4);
          iwv[0] = w0[0]; iwv[1] = w0[1]; iwv[2] = w0[2]; iwv[3] = w0[3]; iwv[4] = w1[0]; iwv[5] = w1[1]; iwv[6] = w1[2]; iwv[7] = w1[3]; }
        const int nkb = 4 * ntl, nchunk = (ntl + 3) >> 2;
        const int srw = tid >> 3, sch = tid & 7;
        const GAS bf16_t* kgp = HA + (rowbase + srw) * LDH + 3072 + sch * 8;
        u32x4 kr[4];
#pragma unroll
        for (int i = 0; i < 4; ++i) if (i < ntl) kr[i] = *(const GAS u32x4*)(kgp + (size_t)(i * 64) * LDH);
#pragma unroll
        for (int i = 0; i < 4; ++i) if (i < ntl) *(LAS u32x4*)((LAS bf16_t*)lds + (i * 64 + srw) * 72 + sch * 8) = kr[i];
        __syncthreads();
        for (int c = 0; c < nchunk; ++c) {
            const int cur = c & 1; const bool more = c + 1 < nchunk;
            if (more) {
#pragma unroll
                for (int i = 0; i < 4; ++i) { const int tl = (c + 1) * 4 + i; if (tl < ntl) kr[i] = *(const GAS u32x4*)(kgp + (size_t)(tl * 64) * LDH); }
            }
            const LAS bf16_t* Kc = (const LAS bf16_t*)(lds + cur * 36864);
#pragma unroll 2
            for (int i = 0; i < 8; ++i) {
                const int kbl = (wid >> 2) + 2 * i, kb = c * 16 + kbl;
                if (kb < nkb) {
                    const LAS bf16_t* kp = Kc + (kbl * 16 + c16) * 72 + lg * 8;
                    const bf16x8 k0 = *(const LAS bf16x8*)kp, k1 = *(const LAS bf16x8*)(kp + 32);
                    f32x4 sc = (f32x4){0.f, 0.f, 0.f, 0.f};
#pragma unroll
                    for (int hh = 0; hh < 8; ++hh) {
                        f32x4 acc = __builtin_amdgcn_mfma_f32_16x16x32_bf16(k0, iqf[hh][0], (f32x4){0.f, 0.f, 0.f, 0.f}, 0, 0, 0);
                        acc = __builtin_amdgcn_mfma_f32_16x16x32_bf16(k1, iqf[hh][1], acc, 0, 0, 0);
#pragma unroll
                        for (int r = 0; r < 4; ++r) sc[r] += iwv[hh] * fmaxf(acc[r], 0.f);
                    }
                    *(GAS f32x4*)(scr + (size_t)ql * SEQ + kb * 16 + 4 * lg) = sc;
                }
            }
            if (more) {
#pragma unroll
                for (int i = 0; i < 4; ++i) { const int tl = (c + 1) * 4 + i; if (tl < ntl) *(LAS u32x4*)((LAS bf16_t*)(lds + (cur ^ 1) * 36864) + (i * 64 + srw) * 72 + sch * 8) = kr[i]; }
            }
            __syncthreads();
        }
    }
    asm volatile("s_waitcnt vmcnt(0)" ::: "memory");
    __syncthreads();
    l1_inv();
    GAS unsigned long long* mb0 = MB + (rowbase + qc * 64 + wid * 8) * 32;
    if (ntl <= 4) {
        for (int rr = 0; rr < 8; ++rr) if (lane < 32) mb0[rr * 32 + lane] = (lane < ntl) ? ~0ull : 0ull;
        return;
    }
    LAS unsigned* hist = (LAS unsigned*)(lds + 73728) + wid * 384;
    LAS unsigned* kbuf = (LAS unsigned*)lds + wid * 2048;
    const GAS float* sr0 = scr + (size_t)(wid * 8) * SEQ + lane;
    switch ((ntl + 7) >> 3) {
        case 1: select_rows<8>(sr0, mb0, hist, kbuf, ntl, lane); break;
        case 2: select_rows<16>(sr0, mb0, hist, kbuf, ntl, lane); break;
        case 3: select_rows<24>(sr0, mb0, hist, kbuf, ntl, lane); break;
        default: select_rows<32>(sr0, mb0, hist, kbuf, ntl, lane); break;
    }
}

__device__ __forceinline__ void ln_phase(const GAS bf16_t* Y, GAS bf16_t* XB, GAS float* OUT, const GAS float* g, const GAS float* bta, bool write_bf) {
    const int tid = opaque_tid(), lane = tid & 63, wid = tid >> 6;
    const int gw = blockIdx.x * 8 + wid, NGW = gridDim.x * 8;
    f32x4 gv[4], bv[4];
#pragma unroll
    for (int j = 0; j < 4; ++j) { gv[j] = *(const GAS f32x4*)(g + 4 * lane + 256 * j); bv[j] = *(const GAS f32x4*)(bta + 4 * lane + 256 * j); }
    constexpr int RB = 4;
    for (int row0 = gw; row0 < T_TOK; row0 += RB * NGW) {
        u32x2 w[RB][4];
#pragma unroll
        for (int r = 0; r < RB; ++r) { const int row = min(row0 + r * NGW, T_TOK - 1); const size_t ro = (size_t)row * DM + 4 * lane;
#pragma unroll
            for (int j = 0; j < 4; ++j) w[r][j] = __builtin_nontemporal_load((const GAS u32x2*)(Y + ro + 256 * j)); }
#pragma unroll
        for (int r = 0; r < RB; ++r) {
            const int row = row0 + r * NGW;
            if (row < T_TOK) {
                const size_t ro = (size_t)row * DM + 4 * lane;
                f32x4 v[4]; float s = 0.f;
#pragma unroll
                for (int j = 0; j < 4; ++j) { v[j] = (f32x4){bflo(w[r][j].x), bfhi(w[r][j].x), bflo(w[r][j].y), bfhi(w[r][j].y)}; s += (v[j][0] + v[j][1]) + (v[j][2] + v[j][3]); }
#pragma unroll
                for (int o = 1; o < 64; o <<= 1) s += __shfl_xor(s, o);
                const float mean = s * (1.f / DM); float s2 = 0.f;
#pragma unroll
                for (int j = 0; j < 4; ++j) { v[j] = v[j] - mean; s2 += (v[j][0] * v[j][0] + v[j][1] * v[j][1]) + (v[j][2] * v[j][2] + v[j][3] * v[j][3]); }
#pragma unroll
                for (int o = 1; o < 64; o <<= 1) s2 += __shfl_xor(s2, o);
                const float rstd = 1.f / sqrtf(s2 * (1.f / DM) + LN_EPS);
#pragma unroll
                for (int j = 0; j < 4; ++j) { const f32x4 y = v[j] * rstd * gv[j] + bv[j];
                    if (write_bf) { u32x2 o2; o2.x = cvtpk(y[0], y[1]); o2.y = cvtpk(y[2], y[3]); *(GAS u32x2*)(XB + ro + 256 * j) = o2; }
                    else __builtin_nontemporal_store(y, (GAS f32x4*)(OUT + ro + 256 * j)); }
            }
        }
    }
}

#define XB_TMO      128
#define XB_XCNT(j)  (256  + 64 * (j))
#define XB_XSUB(j)  (1280 + 64 * (j))
#define XB_XGEN(j)  (2304 + 64 * (j))
#define XB_TOP      3328
#define XB_TOPGEN   3392
#define XCD_BAR_WORDS 3456
#define XB_SPIN_CAP (1u << 18)

__device__ __forceinline__ unsigned xb_ld(unsigned* p)              { return __hip_atomic_load(p, __ATOMIC_RELAXED, __HIP_MEMORY_SCOPE_AGENT); }
__device__ __forceinline__ unsigned xb_add(unsigned* p, unsigned v) { return __hip_atomic_fetch_add(p, v, __ATOMIC_RELAXED, __HIP_MEMORY_SCOPE_AGENT); }
__device__ __forceinline__ unsigned xb_xcc_id() { return (unsigned)__builtin_amdgcn_s_getreg((3 << 11) | 20) & 0xFu; }
#define XB_SPIN(cond, bar) do { unsigned _sp = 0; while (cond) { __builtin_amdgcn_s_sleep(1); \
    if ((++_sp & 255u) == 0u) { if (xb_ld(&(bar)[XB_TMO])) break; if (_sp > XB_SPIN_CAP) { atomicAdd(&(bar)[XB_TMO], 1u); break; } } } } while (0)

struct XcdBarrier {
    unsigned* bar; unsigned x;
    volatile LAS unsigned* st;
};

__device__ __forceinline__ XcdBarrier xcd_barrier_post(unsigned* bar, volatile LAS unsigned* st) {
    XcdBarrier b; b.bar = bar; b.x = xb_xcc_id(); b.st = st;
    if (threadIdx.x == 0) (void)xb_add(&bar[XB_XCNT(b.x)], 1u);
    return b;
}
__device__ __forceinline__ void xcd_barrier_complete(unsigned* bar, unsigned x, unsigned& nloc, unsigned& nx) {
    const unsigned G = gridDim.x * gridDim.y * gridDim.z;
    unsigned sum, cnt, mine, sp = 0u;
    for (;;) {
        sum = 0u; cnt = 0u; mine = 0u;
#pragma unroll
        for (unsigned j = 0; j < 16; ++j) { const unsigned c = xb_ld(&bar[XB_XCNT(j)]); sum += c; cnt += (c > 0u) ? 1u : 0u; mine = (j == x) ? c : mine; }
        if (sum == G) break;
        __builtin_amdgcn_s_sleep(1);
        if ((++sp & 255u) == 0u) { if (xb_ld(&bar[XB_TMO])) break; if (sp > XB_SPIN_CAP) { atomicAdd(&bar[XB_TMO], 1u); break; } }
    }
    nloc = mine > 0u ? mine : 1u; nx = cnt > 0u ? cnt : 1u;
}

__device__ __forceinline__ void xcd_barrier(const XcdBarrier& b) {
    asm volatile("s_waitcnt vmcnt(0)" ::: "memory");
    __syncthreads();
    if (threadIdx.x == 0) {
        unsigned* bar = b.bar;
        __builtin_amdgcn_s_waitcnt(0);
        unsigned nloc = b.st[0], nx = b.st[1];
        if (nloc == 0u) { xcd_barrier_complete(bar, b.x, nloc, nx); b.st[0] = nloc; b.st[1] = nx; }
        const unsigned old = xb_add(&bar[XB_XSUB(b.x)], 1u);
        const unsigned gen = old / nloc;
        if (old + 1u == (gen + 1u) * nloc) {
            __builtin_amdgcn_fence(__ATOMIC_RELEASE, "agent");
            asm volatile("s_waitcnt vmcnt(0)" ::: "memory");
            const unsigned og = xb_add(&bar[XB_TOP], 1u);
            const unsigned tg = og / nx;
            if (og + 1u == (tg + 1u) * nx) xb_add(&bar[XB_TOPGEN], 1u);
            else XB_SPIN(xb_ld(&bar[XB_TOPGEN]) == tg, bar);
            __builtin_amdgcn_fence(__ATOMIC_ACQUIRE, "agent");
            xb_add(&bar[XB_XGEN(b.x)], 1u);
            asm volatile("s_waitcnt vmcnt(0)" ::: "memory");
        } else {
            XB_SPIN(xb_ld(&bar[XB_XGEN(b.x)]) == gen, bar);
            __builtin_amdgcn_fence(__ATOMIC_ACQUIRE, "agent");
            asm volatile("s_waitcnt vmcnt(0)" ::: "memory");
        }
    }
    __syncthreads();
}


__global__ void __launch_bounds__(512, 2) mega_fwd(Args a) {
    extern __shared__ __attribute__((aligned(16))) unsigned char lds_raw[];
    LAS unsigned char* lds = (LAS unsigned char*)lds_raw;
    LAS unsigned* slot = (LAS unsigned*)(lds + LDS_SLOT);
    cg::grid_group grid = cg::this_grid();
    volatile LAS unsigned* bst = (volatile LAS unsigned*)(lds + LDS_SLOT + 16);
    if (threadIdx.x < 2) bst[threadIdx.x] = 0u;
    __syncthreads();
    (void)xcd_barrier_post((unsigned*)(a.ws + WS_CTL) + 2048, bst);
#define GSYNC() do { XcdBarrier xb_; xb_.bar = (unsigned*)(KA->ws + WS_CTL) + 2048; xb_.x = xb_xcc_id(); xb_.st = (volatile LAS unsigned*)(lds + LDS_SLOT + 16); xcd_barrier(xb_); } while (0)
    const volatile __attribute__((address_space(4))) Args* KA = (const volatile __attribute__((address_space(4))) Args*)__builtin_amdgcn_kernarg_segment_ptr();
#define PH unsigned char* ws = KA->ws; int L = Lc; asm volatile("" : "+s"(ws), "+s"(L)); const unsigned char* wl = ws + WS_W + (size_t)L * W_LAYER; (void)wl
    prologue(lds, a);
    grid.sync();
    for (int Lc = 0; Lc < 2; ++Lc) {
        {
            PH;
            run_gemm(lds, (const bf16_t*)(ws + WS_XB), (const bf16_t*)(wl + WO_IN), T_TOK, NIN, DM, FIn{(GAS bf16_t*)(ws + WS_HA), (GAS float*)(ws + WS_FL), (GAS float*)(ws + WS_IW), (const GAS float*)(ws + WS_TRIG)});
        }
        GSYNC();
        {
            PH;
            unsigned* ctr = (unsigned*)(ws + WS_CTL) + 64 * (2 * L);
            const GAS float* bfg = (const GAS float*)KA->in[3] + L * 6;
            const GAS bf16_t* HA = (const GAS bf16_t*)(ws + WS_HA); const GAS float* FL = (const GAS float*)(ws + WS_FL); const GAS float* IW = (const GAS float*)(ws + WS_IW);
            GAS bf16_t* OC = (GAS bf16_t*)(ws + WS_OC); GAS unsigned long long* MB = (GAS unsigned long long*)(ws + WS_MB);
            GAS float* scr = (GAS float*)(ws + WS_SCR) + (size_t)blockIdx.x * 64 * SEQ;
            for (;;) {
                const int u = next_unit(ctr, slot); if (u >= 3840) break;
                const int lev = 7 - u / 480, rem = u % 480;
                if (rem < 192) { const int b = rem / 6, h = rem % 6; attn_unit<0>(lds, HA, b, lev, h * 64, 384 + h * 64, 768 + h * 64, OC, h * 64, FL + h, bfg[h], MB); }
                else if (rem < 352) { const int e = rem - 192, b = e / 5, h = e % 5; attn_unit<1>(lds, HA, b, lev, 1152 + h * 64, 1472 + h * 64, 1792 + h * 64, OC + OC_STRIDE, h * 64, FL, 0.f, MB); }
                else { const int s = rem - 352, qc = 4 * lev + 3 - (s >> 5), b = s & 31; select_unit(lds, HA, IW, b, qc, scr, MB); }
            }
        }
        GSYNC();
        {
            PH;
            unsigned* ctr = (unsigned*)(ws + WS_CTL) + 64 * (2 * L + 1);
            const GAS bf16_t* HA = (const GAS bf16_t*)(ws + WS_HA); GAS bf16_t* OC = (GAS bf16_t*)(ws + WS_OC); const GAS unsigned long long* MB = (const GAS unsigned long long*)(ws + WS_MB);
            for (;;) {
                const int u = next_unit(ctr, slot); if (u >= 1280) break;
                const int qb = 7 - u / 160, e = u % 160, b = e / 5, h = e % 5;
                attn_unit<2>(lds, HA, b, qb, 2112 + h * 64, 2432, 2496, OC + 2 * OC_STRIDE, h * 64, (const GAS float*)nullptr, 0.f, MB);
            }
        }
        GSYNC();
        for (int ui = 0; ui < 64; ++ui) {
            pg8::Unit u;
            { pg8::StaticOrder S; S.init(T_TOK, DM, (int)gridDim.x, (int)blockIdx.x); if (!S.next(ui, u)) break; }
            { PH;
              GAS unsigned char* Gt = (GAS unsigned char*)(ws + WS_MF + (size_t)blockIdx.x * 393216);
              run_gemm_tri(lds, (const bf16_t*)(ws + WS_XB), (const bf16_t*)(wl + WO_G), T_TOK, 3 * DM, DM, TriUnit{u.pm, u.pn, 0}, FGateT3{Gt, 256 * u.pm, 256 * u.pn}); }
            { PH;
              GAS unsigned char* Gt = (GAS unsigned char*)(ws + WS_MF + (size_t)blockIdx.x * 393216);
              l1_inv();
              run_gemm_chain(lds, (const bf16_t*)(ws + WS_OC), (const bf16_t*)(wl + WO_UP), 3 * T_TOK, 3 * DM, OCW, TriUnit{u.pm, u.pn, 256},
                             EpiUpChain{Gt, (GAS bf16_t*)(ws + WS_G), 256 * u.pm, 256 * u.pn}); }
        }
        GSYNC();
        {
            PH;
            run_gemm(lds, (const bf16_t*)(ws + WS_G), (const bf16_t*)(wl + WO_OUT), T_TOK, DM, DM, FOut{L == 0 ? (const GAS float*)KA->in[0] : (const GAS float*)nullptr, (const GAS bf16_t*)(ws + WS_XB), (GAS bf16_t*)(ws + WS_PG)});
        }
        GSYNC();
        {
            PH;
            ln_phase((const GAS bf16_t*)(ws + WS_PG), (GAS bf16_t*)(ws + WS_XB), (GAS float*)KA->out, (const GAS float*)KA->in[8] + L * DM, (const GAS float*)KA->in[9] + L * DM, true);
            const GAS u32x4* ps = (const GAS u32x4*)(ws + WS_PB) + (size_t)L * T_TOK * 32; GAS bf16_t* hf = (GAS bf16_t*)(ws + WS_HFF);
            for (size_t i = (size_t)blockIdx.x * 512 + opaque_tid(); i < (size_t)T_TOK * 32; i += (size_t)gridDim.x * 512) *(GAS u32x4*)(hf + (i >> 5) * HFP + (i & 31) * 8) = ps[i];
        }
        GSYNC();
        {
            PH;
            run_gemm(lds, (const bf16_t*)(ws + WS_XB), (const bf16_t*)(wl + WO_FF1), T_TOK, NFF1, DM, FFf1{(GAS bf16_t*)(ws + WS_HFF), (GAS bf16_t*)(ws + WS_PG)});
        }
        GSYNC();
        {
            PH;
            run_gemm_ff2(lds, (const bf16_t*)(ws + WS_HFF), (const bf16_t*)(wl + WO_FF2), T_TOK, DM, HFP, EpiFf2{(const GAS bf16_t*)(ws + WS_XB), (GAS bf16_t*)(ws + WS_PG)});
        }
        GSYNC();
        {
            PH;
            ln_phase((const GAS bf16_t*)(ws + WS_PG), (GAS bf16_t*)(ws + WS_XB), (GAS float*)KA->out, (const GAS float*)KA->in[14] + L * DM, (const GAS float*)KA->in[15] + L * DM, L == 0);
        }
        if (Lc == 0) GSYNC();
    }
#undef PH
}

extern "C" void kernel_launch(void* const* d_in, const int* in_sizes, int n_in, void* d_out, int out_size, void* d_ws, size_t ws_size, hipStream_t stream) {
    static int grid_blocks = 0;
    if (grid_blocks == 0) {
        if (n_in != 16 || out_size != T_TOK * DM || ws_size < WS_END) { fprintf(stderr, "kernel_launch: unexpected problem (n_in %d out %d ws %zu, need %zu)\n", n_in, out_size, ws_size, (size_t)WS_END); grid_blocks = -1; return; }
        int dev = 0, cus = 0, per_cu = 0;
        hipGetDevice(&dev);
        hipDeviceGetAttribute(&cus, hipDeviceAttributeMultiprocessorCount, dev);
        hipFuncSetAttribute((const void*)mega_fwd, hipFuncAttributeMaxDynamicSharedMemorySize, LDS_BYTES);
        hipOccupancyMaxActiveBlocksPerMultiprocessor(&per_cu, (const void*)mega_fwd, 512, LDS_BYTES);
        if (per_cu < 1) { fprintf(stderr, "kernel_launch: occupancy query returned %d\n", per_cu); per_cu = 1; }
        grid_blocks = cus * per_cu;
        (void)hipGetLastError();
    }
    if (grid_blocks < 0) return;
    hipMemsetAsync((char*)d_ws + WS_CTL, 0, 32768, stream);
    Args a{};
    for (int i = 0; i < 16; ++i) a.in[i] = (const float*)d_in[i];
    a.out = (float*)d_out; a.ws = (unsigned char*)d_ws;
    void* args[] = {&a};
    hipError_t e = hipLaunchCooperativeKernel((const void*)mega_fwd, dim3(grid_blocks), dim3(512), args, LDS_BYTES, stream);
    if (e != hipSuccess) fprintf(stderr, "cooperative launch failed: %s (grid %d)\n", hipGetErrorString(e), grid_blocks);
}
```

```cpp
#include <hip/hip_runtime.h>
#include <hip/hip_cooperative_groups.h>
#include <cstdio>
#include <cstdint>
namespace cg = cooperative_groups;
__device__ __forceinline__ int opaque_tid() { int t = (int)threadIdx.x; asm volatile("" : "+v"(t)); return t; }
namespace pg8 {
#define PG8_LAS __attribute__((address_space(3)))
typedef unsigned short bf16_t;
typedef short bf16x8 __attribute__((ext_vector_type(8)));
typedef float f32x4 __attribute__((ext_vector_type(4)));
typedef unsigned u32x4 __attribute__((ext_vector_type(4)));
constexpr int BM = 256, BK = 64, HALF = 128, HTB = HALF * BK * 2, STAGE_BYTES = 8 * HTB, NXCD = 8, WGM = 4;

__host__ __device__ __forceinline__ int lds_byte(int r, int c) { const int st = (r >> 4) * 2 + (c >> 5), rr = r & 15, cc = c & 31, ob = rr * 64 + cc * 2; return st * 1024 + (ob ^ (((ob >> 9) & 1) << 5)); }
__host__ __device__ __forceinline__ void stage_rc(int b, int& R, int& C) { const int st = b / 1024, sb = b % 1024, swz = sb ^ (((sb >> 9) & 1) << 5); R = (st >> 1) * 16 + swz / 64; C = (st & 1) * 32 + (swz % 64) / 2; }
__host__ __device__ __forceinline__ int perm32(int rho) { const int n = rho >> 4, i = rho & 15; return 8 * (i >> 2) + 4 * n + (i & 3); }

struct Unit { int pm, pn; };
struct Gemm { const bf16_t* A; const bf16_t* Bt; int M, N, K; };

struct StaticOrder {
    int nM, nN, nwg, G, c;
    __host__ __device__ __forceinline__ void init(int M, int N, int G_, int c_) { nM = M / BM; nN = N / BM; nwg = nM * nN; G = G_; c = c_; }
    __host__ __device__ __forceinline__ bool next(int i, Unit& u) const {
        const long L = (long)i * G + c; if (L >= nwg) return false;
        int wgid = (int)L; { const int q = nwg / NXCD, r = nwg % NXCD, xcd = wgid % NXCD, off = wgid / NXCD; wgid = (xcd < r ? xcd * (q + 1) : r * (q + 1) + (xcd - r) * q) + off; }
        const int nig = WGM * nN, gid = wgid / nig, fm = gid * WGM, gsz = (nM - fm) < WGM ? (nM - fm) : WGM;
        u.pm = fm + ((wgid % nig) % gsz); u.pn = (wgid % nig) / gsz; return true;
    }
    __device__ __forceinline__ void a_ready(const Unit&) const {}
    __device__ __forceinline__ void done(const Unit&) const {}
};

template <class Epi, class Sched, bool ALIGN_EPI = false, bool SP2 = false>
__device__ __forceinline__ void gemm_phase(PG8_LAS unsigned char* lds, const Gemm g, const Sched& S, const Epi& E) {
    const int tid = opaque_tid(), wid = __builtin_amdgcn_readfirstlane(tid >> 6), lane = tid & 63, wr = wid >> 2, wc = wid & 3, fr = lane & 15, fq = lane >> 4;
    const int K = g.K, nt = K / BK;
    unsigned voffA[2], voffB[2];
#pragma unroll
    for (int i = 0; i < 2; ++i) { int R, C; stage_rc(tid * 16 + i * 8192, R, C); const int Rb = Epi::PERM ? ((R & ~31) + perm32(R & 31)) : R;
        voffA[i] = (unsigned)(R * K + C) * 2u; voffB[i] = (unsigned)(Rb * K + C) * 2u; }
    const size_t kstep = (size_t)(BK * 2);
    const size_t hstep = (size_t)HALF * K * 2;
    const size_t tstep = 2 * hstep;
    const unsigned ldsw = (unsigned)wid * 1024u;
    const int aoff = lds_byte(wr * 64 + fr, fq * 8), boff = lds_byte(wc * 32 + fr, fq * 8);
#define PG8_SA(b, h) (((b) * 2 + (h)) * HTB)
#define PG8_SB(b, h) ((4 + (b) * 2 + (h)) * HTB)
#define PG8_STAGE(bufoff, gbase, voff) do { _Pragma("unroll") for (int _i = 0; _i < 2; ++_i) \
        __builtin_amdgcn_global_load_lds((const unsigned*)((const char*)(gbase) + (voff)[_i]), (PG8_LAS unsigned*)(lds + (bufoff) + ldsw + _i * 8192), 16, 0, 0); } while (0)
#define PG8_LDA(dst, b, h) do { _Pragma("unroll") for (int m = 0; m < 4; ++m) _Pragma("unroll") for (int k = 0; k < 2; ++k) dst[m][k] = *(const PG8_LAS bf16x8*)(lds + PG8_SA(b, h) + aoff + m * 2048 + k * 1024); } while (0)
#define PG8_LDB(dst, b, h) do { _Pragma("unroll") for (int n = 0; n < 2; ++n) _Pragma("unroll") for (int k = 0; k < 2; ++k) dst[n][k] = *(const PG8_LAS bf16x8*)(lds + PG8_SB(b, h) + boff + n * 2048 + k * 1024); } while (0)
#define PG8_MMA(ai, bj, At, Bt) do { __builtin_amdgcn_s_setprio(1); _Pragma("unroll") for (int m = 0; m < 4; ++m) _Pragma("unroll") for (int n = 0; n < 2; ++n) _Pragma("unroll") for (int k = 0; k < 2; ++k) \
        acc[ai][bj][m][n] = __builtin_amdgcn_mfma_f32_16x16x32_bf16(Bt[n][k], At[m][k], acc[ai][bj][m][n], 0, 0, 0); __builtin_amdgcn_s_setprio(0); } while (0)
#define PG8_WAIT_V(n) asm volatile("s_waitcnt vmcnt(" #n ")" ::: "memory")
#define PG8_WAIT_L(n) asm volatile("s_waitcnt lgkmcnt(" #n ")" ::: "memory")
#define PG8_BAR __builtin_amdgcn_s_barrier()
#define PG8_SCHED __builtin_amdgcn_sched_barrier(0)
    Unit cur, nxt; int ui = 0;
    if (!S.next(0, cur)) return;
    f32x4 acc[2][2][4][2];
#pragma unroll
    for (int a = 0; a < 2; ++a)
#pragma unroll
        for (int b = 0; b < 2; ++b)
#pragma unroll
            for (int m = 0; m < 4; ++m)
#pragma unroll
                for (int n = 0; n < 2; ++n) acc[a][b][m][n] = (f32x4){0.f, 0.f, 0.f, 0.f};
    bf16x8 At[4][2], B0[2][2], B1[2][2];
    const char* cA = (const char*)g.A + (size_t)cur.pm * tstep; const char* cB = (const char*)g.Bt + (size_t)cur.pn * tstep;
    S.a_ready(cur);
    if constexpr (SP2) {
        PG8_STAGE(PG8_SB(0, 0), cB, voffB); PG8_STAGE(PG8_SB(0, 1), cB + hstep, voffB); PG8_STAGE(PG8_SA(0, 0), cA, voffA); PG8_STAGE(PG8_SA(0, 1), cA + hstep, voffA);
        if (wr == 1) PG8_BAR;
        PG8_WAIT_V(2); PG8_BAR;
        PG8_STAGE(PG8_SB(1, 0), cB + kstep, voffB); PG8_STAGE(PG8_SA(1, 0), cA + kstep, voffA); PG8_STAGE(PG8_SB(1, 1), cB + hstep + kstep, voffB);
        PG8_WAIT_V(6); PG8_BAR;
    } else {
        PG8_STAGE(PG8_SB(0, 0), cB, voffB); PG8_STAGE(PG8_SA(0, 0), cA, voffA); PG8_STAGE(PG8_SB(0, 1), cB + hstep, voffB); PG8_STAGE(PG8_SA(0, 1), cA + hstep, voffA);
        if (wr == 1) PG8_BAR;
        PG8_WAIT_V(4); PG8_BAR;
        PG8_STAGE(PG8_SB(1, 0), cB + kstep, voffB); PG8_STAGE(PG8_SA(1, 0), cA + kstep, voffA); PG8_STAGE(PG8_SB(1, 1), cB + hstep + kstep, voffB);
        PG8_WAIT_V(6); PG8_BAR;
    }
    for (;;) {
        const bool has_next = S.next(ui + 1, nxt);
        const char* nA = has_next ? (const char*)g.A + (size_t)nxt.pm * tstep : cA; const char* nB = has_next ? (const char*)g.Bt + (size_t)nxt.pn * tstep : cB;
        constexpr int NSEG = Epi::MIDK > 0 ? 2 : 1;
#pragma unroll
        for (int seg = 0; seg < NSEG; ++seg) {
        const int t0 = (NSEG == 2 && seg == 1) ? Epi::MIDK : 0, t1 = (NSEG == 2 && seg == 0) ? Epi::MIDK : nt;
        if constexpr (Epi::MIDK > 0) { if (seg == 1) E.mid(acc, cur, wr, wc, fr, fq); }
#pragma unroll 1
        for (int t = t0; t < t1; t += 2) {
            const bool last = (t == nt - 2);
            const char* a1 = cA + (size_t)(t + 1) * kstep;
            const char* a2 = last ? nA : cA + (size_t)(t + 2) * kstep; const char* b2 = last ? nB : cB + (size_t)(t + 2) * kstep;
            const char* a3 = a2 + kstep; const char* b3 = b2 + kstep;
            if (last && has_next) S.a_ready(nxt);
            if constexpr (SP2) {
            PG8_LDB(B0, 0, 0); PG8_LDB(B1, 0, 1); PG8_SCHED; PG8_LDA(At, 0, 0); PG8_STAGE(PG8_SA(1, 1), a1 + hstep, voffA);
            PG8_WAIT_V(8); PG8_WAIT_L(0); PG8_BAR; PG8_MMA(0, 0, At, B0); PG8_MMA(0, 1, At, B1); PG8_BAR; PG8_SCHED;
            PG8_LDA(At, 0, 1); PG8_STAGE(PG8_SB(0, 0), b2, voffB); PG8_STAGE(PG8_SB(0, 1), b2 + hstep, voffB); PG8_STAGE(PG8_SA(0, 0), a2, voffA);
            PG8_WAIT_V(8); PG8_WAIT_L(0); PG8_BAR; PG8_MMA(1, 0, At, B0); PG8_MMA(1, 1, At, B1); PG8_BAR; PG8_SCHED;
            PG8_LDB(B0, 1, 0); PG8_LDB(B1, 1, 1); PG8_SCHED; PG8_LDA(At, 1, 0); PG8_STAGE(PG8_SA(0, 1), a2 + hstep, voffA);
            PG8_WAIT_V(8); PG8_WAIT_L(0); PG8_BAR; PG8_MMA(0, 0, At, B0); PG8_MMA(0, 1, At, B1); PG8_BAR; PG8_SCHED;
            PG8_LDA(At, 1, 1); PG8_STAGE(PG8_SB(1, 0), b3, voffB); PG8_STAGE(PG8_SB(1, 1), b3 + hstep, voffB); PG8_STAGE(PG8_SA(1, 0), a3, voffA);
            PG8_WAIT_V(8); PG8_WAIT_L(0); PG8_BAR; PG8_MMA(1, 0, At, B0); PG8_MMA(1, 1, At, B1); PG8_BAR; PG8_SCHED;
            } else {
            PG8_LDB(B0, 0, 0); PG8_SCHED; PG8_LDA(At, 0, 0); PG8_STAGE(PG8_SA(1, 1), a1 + hstep, voffA);
            PG8_WAIT_L(8); PG8_BAR; PG8_WAIT_L(0); PG8_MMA(0, 0, At, B0); PG8_BAR; PG8_SCHED;
            PG8_LDB(B1, 0, 1); PG8_STAGE(PG8_SB(0, 0), b2, voffB);
            PG8_BAR; PG8_WAIT_L(0); PG8_MMA(0, 1, At, B1); PG8_BAR;
            PG8_LDA(At, 0, 1); PG8_STAGE(PG8_SA(0, 0), a2, voffA);
            PG8_BAR; PG8_WAIT_L(0); PG8_MMA(1, 0, At, B0); PG8_BAR; PG8_SCHED;
            PG8_STAGE(PG8_SB(0, 1), b2 + hstep, voffB);
            PG8_WAIT_V(6); PG8_BAR; PG8_MMA(1, 1, At, B1); PG8_BAR;
            PG8_LDB(B0, 1, 0); PG8_SCHED; PG8_LDA(At, 1, 0); PG8_STAGE(PG8_SA(0, 1), a2 + hstep, voffA);
            PG8_WAIT_L(8); PG8_BAR; PG8_WAIT_L(0); PG8_MMA(0, 0, At, B0); PG8_BAR; PG8_SCHED;
            PG8_LDB(B1, 1, 1); PG8_STAGE(PG8_SB(1, 0), b3, voffB);
            PG8_BAR; PG8_WAIT_L(0); PG8_MMA(0, 1, At, B1); PG8_BAR;
            PG8_LDA(At, 1, 1); PG8_STAGE(PG8_SA(1, 0), a3, voffA);
            PG8_BAR; PG8_WAIT_L(0); PG8_MMA(1, 0, At, B0); PG8_BAR; PG8_SCHED;
            PG8_STAGE(PG8_SB(1, 1), b3 + hstep, voffB);
            PG8_WAIT_V(6); PG8_BAR; PG8_MMA(1, 1, At, B1); PG8_BAR;
            }
        }
        }
        if constexpr (ALIGN_EPI) { if (wr == 0) PG8_BAR; }
        if constexpr (Epi::CHAIN) {
            E.chain(acc, cur, has_next, wr, wc, fr, fq); S.done(cur);
            if (!has_next) break;
        } else {
        if constexpr (!Epi::AFTER_DRAIN) { E(acc, cur, wr, wc, fr, fq); S.done(cur); }
        if (!has_next) break;
#pragma unroll
        for (int a = 0; a < 2; ++a)
#pragma unroll
            for (int b = 0; b < 2; ++b)
#pragma unroll
                for (int m = 0; m < 4; ++m)
#pragma unroll
                    for (int n = 0; n < 2; ++n) acc[a][b][m][n] = (f32x4){0.f, 0.f, 0.f, 0.f};
        }
        cur = nxt; cA = nA; cB = nB; ++ui;
        if constexpr (ALIGN_EPI) { if (wr == 1) PG8_BAR; }
    }
    PG8_WAIT_V(0);
    if constexpr (!ALIGN_EPI) { if (wr == 0) PG8_BAR; }
    PG8_BAR;
    if constexpr (Epi::AFTER_DRAIN) { E.fused(acc, cur, wr, wc, fr, fq, lds, wid, lane); S.done(cur); }
#undef PG8_SA
#undef PG8_SB
#undef PG8_STAGE
#undef PG8_LDA
#undef PG8_LDB
#undef PG8_MMA
#undef PG8_WAIT_V
#undef PG8_WAIT_L
#undef PG8_BAR
#undef PG8_SCHED
}
}
using pg8::bf16_t; using pg8::bf16x8; using pg8::f32x4; using pg8::u32x4;
#define LAS __attribute__((address_space(3)))
#define GAS __attribute__((address_space(1)))
typedef float f32x16 __attribute__((ext_vector_type(16)));
typedef short s16x4 __attribute__((ext_vector_type(4)));
typedef float f32x2_t __attribute__((ext_vector_type(2)));
typedef __bf16 bf16x2_t __attribute__((ext_vector_type(2)));
typedef unsigned u32x2 __attribute__((ext_vector_type(2)));
typedef short v4i16_t __attribute__((ext_vector_type(4)));
#define MFMA32(a, b, c) __builtin_amdgcn_mfma_f32_32x32x16_bf16((a), (b), (c), 0, 0, 0)

constexpr int T_TOK = 65536, SEQ = 2048, DM = 1024, LDH = 3136, NIN = 3328, CIN = 6222, DFF = 4096, NFF1 = 5120, OCW = 384, HFP = 256 + DFF;
constexpr float ALPHA = 1.4142135623730951f, L2E = 1.4426950408889634f, LN_EPS = 1e-5f, NEGF = -1e30f;
constexpr size_t MiB = (size_t)1 << 20;
constexpr size_t WS_CTL = 0, WS_TRIG = 1 * MiB, WS_W = 2 * MiB, W_LAYER = 40 * MiB;
constexpr size_t WO_IN = 0, WO_G = 7 * MiB, WO_UP = 13 * MiB, WO_OUT = 16 * MiB, WO_FF1 = 18 * MiB, WO_FF2 = 28 * MiB, WO_PLE = 36 * MiB;
constexpr size_t WS_PB = 82 * MiB, WS_MB = 146 * MiB, WS_FL = 162 * MiB, WS_IW = 164 * MiB, WS_XB = 166 * MiB, WS_OC = 294 * MiB, WS_A = 438 * MiB;
constexpr size_t WS_HA = WS_A, WS_SCR = WS_A + 392 * MiB, WS_HFF = WS_A, WS_MF = WS_A, WS_G = WS_A + 256 * MiB, WS_PG = WS_OC, WS_END = 984 * MiB;
constexpr size_t OC_STRIDE = (size_t)T_TOK * OCW;
constexpr int LDS_SLOT = 131072, LDS_BYTES = 131072 + 256;

__device__ __forceinline__ unsigned cvtpk(float lo, float hi) { f32x2_t v = {lo, hi}; bf16x2_t b = __builtin_convertvector(v, bf16x2_t); return __builtin_bit_cast(unsigned, b); }
__device__ __forceinline__ float bflo(unsigned w) { return __uint_as_float(w << 16); }
__device__ __forceinline__ float bfhi(unsigned w) { return __uint_as_float(w & 0xffff0000u); }
__device__ __forceinline__ u32x4 pack8(f32x4 a, f32x4 b) { u32x4 w; w.x = cvtpk(a[0], a[1]); w.y = cvtpk(a[2], a[3]); w.z = cvtpk(b[0], b[1]); w.w = cvtpk(b[2], b[3]); return w; }
__device__ __forceinline__ float ex2(float x) { return __builtin_amdgcn_exp2f(x); }
__device__ __forceinline__ float sigm(float x) { return __builtin_amdgcn_rcpf(1.f + ex2(-x * L2E)); }
__device__ __forceinline__ void l1_inv() { __builtin_amdgcn_fence(__ATOMIC_ACQUIRE, "agent"); }

struct NoLoad {};
template <class F> struct EpiF {
    static constexpr bool PERM = true, AFTER_DRAIN = false, CHAIN = false; static constexpr int MIDK = 0; F f;
    __device__ __forceinline__ void operator()(const f32x4 (&acc)[2][2][4][2], const pg8::Unit& u, int wr, int wc, int fr, int fq) const {
        const int row0 = u.pm * 256 + wr * 64 + fr, col0 = u.pn * 256 + wc * 32 + 8 * fq;
        f.begin();
        typename F::L cur0 = f.load(row0, col0), cur1 = f.load(row0, col0 + 128);
#pragma unroll
        for (int b = 0; b < 8; ++b) {
            const int row = row0 + (b >> 2) * 128 + (b & 3) * 16;
            typename F::L nxt0 = cur0, nxt1 = cur1;
            if (b + 1 < 8) { const int rn = row0 + ((b + 1) >> 2) * 128 + ((b + 1) & 3) * 16; nxt0 = f.load(rn, col0); nxt1 = f.load(rn, col0 + 128); }
            f.apply(row, col0, acc[b >> 2][0][b & 3][0], acc[b >> 2][0][b & 3][1], cur0);
            f.apply(row, col0 + 128, acc[b >> 2][1][b & 3][0], acc[b >> 2][1][b & 3][1], cur1);
            cur0 = nxt0; cur1 = nxt1;
        }
    }
};
struct FIn {
    struct L { f32x4 t0, t1; };
    GAS bf16_t* HA; GAS float* FL; GAS float* IW; const GAS float* cs;
    __device__ __forceinline__ void begin() const {}
    static __device__ __forceinline__ bool is_rope(int c0) { return (c0 >= 2112 && c0 < 2496) || (c0 >= 2560 && c0 < 3136); }
    __device__ __forceinline__ L load(int row, int c0) const {
        L l; l.t0 = (f32x4){1.f, 0.f, 1.f, 0.f}; l.t1 = l.t0;
        if (is_rope(c0)) { const int pos = row & (SEQ - 1), i0 = (c0 & 63) >> 1; const GAS float* tp = cs + ((size_t)pos * 32 + i0) * 2; l.t0 = *(const GAS f32x4*)tp; l.t1 = *(const GAS f32x4*)(tp + 4); }
        return l;
    }
    __device__ __forceinline__ void apply(int row, int c0, f32x4 v0, f32x4 v1, const L& l) const {
        if (c0 >= 3152) return;
        if (c0 >= 3136) { GAS float* d = (c0 == 3136 ? FL : IW) + (size_t)row * 8; *(GAS f32x4*)d = v0; *(GAS f32x4*)(d + 4) = v1; return; }
        if (is_rope(c0)) {
            const f32x4 t0 = l.t0, t1 = l.t1;
            float a, b;
            a = v0[0] * t0[0] - v0[1] * t0[1]; b = v0[1] * t0[0] + v0[0] * t0[1]; v0[0] = a; v0[1] = b;
            a = v0[2] * t0[2] - v0[3] * t0[3]; b = v0[3] * t0[2] + v0[2] * t0[3]; v0[2] = a; v0[3] = b;
            a = v1[0] * t1[0] - v1[1] * t1[1]; b = v1[1] * t1[0] + v1[0] * t1[1]; v1[0] = a; v1[1] = b;
            a = v1[2] * t1[2] - v1[3] * t1[3]; b = v1[3] * t1[2] + v1[2] * t1[3]; v1[2] = a; v1[3] = b;
        }
        const bool isq = (c0 < 384) || (c0 >= 1152 && c0 < 1472) || (c0 >= 2112 && c0 < 2432);
        if (isq) { v0 = v0 * (0.125f * L2E); v1 = v1 * (0.125f * L2E); }
        *(GAS u32x4*)(HA + (size_t)row * LDH + c0) = pack8(v0, v1);
    }
};
struct FGateT {
    typedef NoLoad L;
    GAS unsigned char* Gt; int ro, co;
    __device__ __forceinline__ void begin() const {}
    __device__ __forceinline__ L load(int, int) const { return L{}; }
    __device__ __forceinline__ void apply(int row, int c0, f32x4 v0, f32x4 v1, const L&) const {
        u32x2 w; w.x = 0u; w.y = 0u;
        w.x = __builtin_amdgcn_cvt_pk_u8_f32(sigm(v0[0]) * 255.f, 0, w.x); w.x = __builtin_amdgcn_cvt_pk_u8_f32(sigm(v0[1]) * 255.f, 1, w.x);
        w.x = __builtin_amdgcn_cvt_pk_u8_f32(sigm(v0[2]) * 255.f, 2, w.x); w.x = __builtin_amdgcn_cvt_pk_u8_f32(sigm(v0[3]) * 255.f, 3, w.x);
        w.y = __builtin_amdgcn_cvt_pk_u8_f32(sigm(v1[0]) * 255.f, 0, w.y); w.y = __builtin_amdgcn_cvt_pk_u8_f32(sigm(v1[1]) * 255.f, 1, w.y);
        w.y = __builtin_amdgcn_cvt_pk_u8_f32(sigm(v1[2]) * 255.f, 2, w.y); w.y = __builtin_amdgcn_cvt_pk_u8_f32(sigm(v1[3]) * 255.f, 3, w.y);
        *(GAS u32x2*)(Gt + (row - ro) * 256 + (c0 - co)) = w;
    }
};
struct FUpT {
    struct L { u32x2 g; u32x4 m; };
    const GAS unsigned char* Gt; GAS bf16_t* Mt; GAS bf16_t* MG; int ro, co, mode;
    __device__ __forceinline__ void begin() const { l1_inv(); }
    __device__ __forceinline__ L load(int row, int c0) const {
        const int o = (row - ro) * 256 + (c0 - co);
        L l; l.g = *(const GAS u32x2*)(Gt + o); l.m = (u32x4){0u, 0u, 0u, 0u};
        if (mode != 0) l.m = *(const GAS u32x4*)(Mt + o);
        return l;
    }
    __device__ __forceinline__ void apply(int row, int c0, f32x4 v0, f32x4 v1, const L& l) const {
        const int o = (row - ro) * 256 + (c0 - co);
        const float k = 1.f / 255.f; const u32x2 g = l.g; const u32x4 m = l.m;
        f32x4 r0, r1;
        r0[0] = bflo(m.x) + (float)((g.x >> 0) & 0xffu) * k * v0[0]; r0[1] = bfhi(m.x) + (float)((g.x >> 8) & 0xffu) * k * v0[1];
        r0[2] = bflo(m.y) + (float)((g.x >> 16) & 0xffu) * k * v0[2]; r0[3] = bfhi(m.y) + (float)((g.x >> 24) & 0xffu) * k * v0[3];
        r1[0] = bflo(m.z) + (float)((g.y >> 0) & 0xffu) * k * v1[0]; r1[1] = bfhi(m.z) + (float)((g.y >> 8) & 0xffu) * k * v1[1];
        r1[2] = bflo(m.w) + (float)((g.y >> 16) & 0xffu) * k * v1[2]; r1[3] = bfhi(m.w) + (float)((g.y >> 24) & 0xffu) * k * v1[3];
        if (mode != 2) *(GAS u32x4*)(Mt + o) = pack8(r0, r1);
        else *(GAS u32x4*)(MG + (size_t)row * DM + c0) = pack8(r0, r1);
    }
};
struct FGateT3 {
    typedef NoLoad L;
    GAS unsigned char* Gt; int ro, co;
    __device__ __forceinline__ void begin() const {}
    __device__ __forceinline__ L load(int, int) const { return L{}; }
    __device__ __forceinline__ void apply(int row, int c0, f32x4 v0, f32x4 v1, const L&) const {
        const int j = c0 >> 10;
        u32x2 w; w.x = 0u; w.y = 0u;
        w.x = __builtin_amdgcn_cvt_pk_u8_f32(sigm(v0[0]) * 255.f, 0, w.x); w.x = __builtin_amdgcn_cvt_pk_u8_f32(sigm(v0[1]) * 255.f, 1, w.x);
        w.x = __builtin_amdgcn_cvt_pk_u8_f32(sigm(v0[2]) * 255.f, 2, w.x); w.x = __builtin_amdgcn_cvt_pk_u8_f32(sigm(v0[3]) * 255.f, 3, w.x);
        w.y = __builtin_amdgcn_cvt_pk_u8_f32(sigm(v1[0]) * 255.f, 0, w.y); w.y = __builtin_amdgcn_cvt_pk_u8_f32(sigm(v1[1]) * 255.f, 1, w.y);
        w.y = __builtin_amdgcn_cvt_pk_u8_f32(sigm(v1[2]) * 255.f, 2, w.y); w.y = __builtin_amdgcn_cvt_pk_u8_f32(sigm(v1[3]) * 255.f, 3, w.y);
        *(GAS u32x2*)(Gt + j * 65536 + (row - ro) * 256 + ((c0 & 1023) - co)) = w;
    }
};
struct FUpT3 {
    struct L { u32x2 g; u32x4 m; };
    const GAS unsigned char* Gt; GAS bf16_t* Mt; GAS bf16_t* MG; int ro, co;
    __device__ __forceinline__ void begin() const { l1_inv(); }
    __device__ __forceinline__ L load(int row, int c0) const {
        const int j = c0 >> 10; const int o = (row - j * T_TOK - ro) * 256 + ((c0 & 1023) - co);
        L l; l.g = *(const GAS u32x2*)(Gt + j * 65536 + o); l.m = (u32x4){0u, 0u, 0u, 0u};
        if (j != 0) l.m = *(const GAS u32x4*)(Mt + o);
        return l;
    }
    __device__ __forceinline__ void apply(int row, int c0, f32x4 v0, f32x4 v1, const L& l) const {
        const int j = c0 >> 10; const int rr = row - j * T_TOK, cc = c0 & 1023; const int o = (rr - ro) * 256 + (cc - co);
        const float k = 1.f / 255.f; const u32x2 g = l.g; const u32x4 m = l.m;
        f32x4 r0, r1;
        r0[0] = bflo(m.x) + (float)((g.x >> 0) & 0xffu) * k * v0[0]; r0[1] = bfhi(m.x) + (float)((g.x >> 8) & 0xffu) * k * v0[1];
        r0[2] = bflo(m.y) + (float)((g.x >> 16) & 0xffu) * k * v0[2]; r0[3] = bfhi(m.y) + (float)((g.x >> 24) & 0xffu) * k * v0[3];
        r1[0] = bflo(m.z) + (float)((g.y >> 0) & 0xffu) * k * v1[0]; r1[1] = bfhi(m.z) + (float)((g.y >> 8) & 0xffu) * k * v1[1];
        r1[2] = bflo(m.w) + (float)((g.y >> 16) & 0xffu) * k * v1[2]; r1[3] = bfhi(m.w) + (float)((g.y >> 24) & 0xffu) * k * v1[3];
        if (j != 2) *(GAS u32x4*)(Mt + o) = pack8(r0, r1);
        else *(GAS u32x4*)(MG + (size_t)rr * DM + cc) = pack8(r0, r1);
    }
};
struct EpiUpChain {
    static constexpr bool PERM = true, AFTER_DRAIN = false, CHAIN = true; static constexpr int MIDK = 0;
    const GAS unsigned char* Gt; GAS bf16_t* MG; int ro, co;
    __device__ __forceinline__ void operator()(const f32x4 (&)[2][2][4][2], const pg8::Unit&, int, int, int, int) const {}
    static __device__ __forceinline__ float gb(unsigned w, int sh) { return (float)max((w >> sh) & 0xffu, 1u); }
    __device__ __forceinline__ void chain(f32x4 (&acc)[2][2][4][2], const pg8::Unit& u, bool has_next, int wr, int wc, int fr, int fq) const {
        const int j = u.pn >> 2;
        const GAS unsigned char* ga_p = Gt + j * 65536 + (wr * 64 + fr) * 256 + wc * 32 + 8 * fq;
        if (has_next) {
#pragma unroll
            for (int h2 = 0; h2 < 2; ++h2) {
                u32x2 ga[8], gn[8];
#pragma unroll
                for (int m = 0; m < 4; ++m)
#pragma unroll
                    for (int bj = 0; bj < 2; ++bj) { const int o = (h2 * 128 + m * 16) * 256 + bj * 128; ga[2 * m + bj] = *(const GAS u32x2*)(ga_p + o); gn[2 * m + bj] = *(const GAS u32x2*)(ga_p + 65536 + o); }
#pragma unroll
                for (int m = 0; m < 4; ++m)
#pragma unroll
                    for (int bj = 0; bj < 2; ++bj) {
                        const u32x2 a = ga[2 * m + bj], n = gn[2 * m + bj];
                        f32x4 v0 = acc[h2][bj][m][0], v1 = acc[h2][bj][m][1];
                        v0[0] *= gb(a.x, 0) * __builtin_amdgcn_rcpf(gb(n.x, 0)); v0[1] *= gb(a.x, 8) * __builtin_amdgcn_rcpf(gb(n.x, 8));
                        v0[2] *= gb(a.x, 16) * __builtin_amdgcn_rcpf(gb(n.x, 16)); v0[3] *= gb(a.x, 24) * __builtin_amdgcn_rcpf(gb(n.x, 24));
                        v1[0] *= gb(a.y, 0) * __builtin_amdgcn_rcpf(gb(n.y, 0)); v1[1] *= gb(a.y, 8) * __builtin_amdgcn_rcpf(gb(n.y, 8));
                        v1[2] *= gb(a.y, 16) * __builtin_amdgcn_rcpf(gb(n.y, 16)); v1[3] *= gb(a.y, 24) * __builtin_amdgcn_rcpf(gb(n.y, 24));
                        acc[h2][bj][m][0] = v0; acc[h2][bj][m][1] = v1;
                    }
            }
        } else {
#pragma unroll
            for (int h2 = 0; h2 < 2; ++h2) {
                u32x2 ga[8];
#pragma unroll
                for (int m = 0; m < 4; ++m)
#pragma unroll
                    for (int bj = 0; bj < 2; ++bj) ga[2 * m + bj] = *(const GAS u32x2*)(ga_p + (h2 * 128 + m * 16) * 256 + bj * 128);
#pragma unroll
                for (int m = 0; m < 4; ++m)
#pragma unroll
                    for (int bj = 0; bj < 2; ++bj) {
                        const u32x2 a = ga[2 * m + bj]; const float k = 1.f / 255.f;
                        f32x4 v0 = acc[h2][bj][m][0], v1 = acc[h2][bj][m][1];
                        v0[0] *= gb(a.x, 0) * k; v0[1] *= gb(a.x, 8) * k; v0[2] *= gb(a.x, 16) * k; v0[3] *= gb(a.x, 24) * k;
                        v1[0] *= gb(a.y, 0) * k; v1[1] *= gb(a.y, 8) * k; v1[2] *= gb(a.y, 16) * k; v1[3] *= gb(a.y, 24) * k;
                        const int row = ro + wr * 64 + fr + h2 * 128 + m * 16, col = co + wc * 32 + 8 * fq + bj * 128;
                        *(GAS u32x4*)(MG + (size_t)row * DM + col) = pack8(v0, v1);
                    }
            }
        }
    }
};
struct EpiFf2 {
    static constexpr bool PERM = true, AFTER_DRAIN = false, CHAIN = false; static constexpr int MIDK = 4;
    const GAS bf16_t* XB; GAS bf16_t* PG;
    __device__ __forceinline__ void mid(f32x4 (&acc)[2][2][4][2], const pg8::Unit& u, int wr, int wc, int fr, int fq) const {
        const size_t base = (size_t)(u.pm * 256 + wr * 64 + fr) * DM + u.pn * 256 + wc * 32 + 8 * fq;
#pragma unroll
        for (int b = 0; b < 8; b += 4) {
            u32x4 g[8], x[8];
#pragma unroll
            for (int i = 0; i < 8; ++i) { const int bb = b + (i >> 1), bj = i & 1; const size_t o = base + (size_t)((bb >> 2) * 128 + (bb & 3) * 16) * DM + bj * 128; g[i] = *(const GAS u32x4*)(PG + o); x[i] = *(const GAS u32x4*)(XB + o); }
#pragma unroll
            for (int i = 0; i < 8; ++i) {
                const int bb = b + (i >> 1), bj = i & 1; const u32x4 gg = g[i], xx = x[i];
                f32x4 v0 = acc[bb >> 2][bj][bb & 3][0], v1 = acc[bb >> 2][bj][bb & 3][1];
                v0[0] = v0[0] * bflo(gg.x) + ALPHA * bflo(xx.x); v0[1] = v0[1] * bfhi(gg.x) + ALPHA * bfhi(xx.x); v0[2] = v0[2] * bflo(gg.y) + ALPHA * bflo(xx.y); v0[3] = v0[3] * bfhi(gg.y) + ALPHA * bfhi(xx.y);
                v1[0] = v1[0] * bflo(gg.z) + ALPHA * bflo(xx.z); v1[1] = v1[1] * bfhi(gg.z) + ALPHA * bfhi(xx.z); v1[2] = v1[2] * bflo(gg.w) + ALPHA * bflo(xx.w); v1[3] = v1[3] * bfhi(gg.w) + ALPHA * bfhi(xx.w);
                acc[bb >> 2][bj][bb & 3][0] = v0; acc[bb >> 2][bj][bb & 3][1] = v1;
            }
        }
        asm volatile("s_waitcnt vmcnt(0)" ::: "memory");
    }
    __device__ __forceinline__ void operator()(const f32x4 (&acc)[2][2][4][2], const pg8::Unit& u, int wr, int wc, int fr, int fq) const {
        const size_t base = (size_t)(u.pm * 256 + wr * 64 + fr) * DM + u.pn * 256 + wc * 32 + 8 * fq;
#pragma unroll
        for (int b = 0; b < 8; ++b)
#pragma unroll
            for (int bj = 0; bj < 2; ++bj)
                *(GAS u32x4*)(PG + base + (size_t)((b >> 2) * 128 + (b & 3) * 16) * DM + bj * 128) = pack8(acc[b >> 2][bj][b & 3][0], acc[b >> 2][bj][b & 3][1]);
    }
};
struct TriUnit {
    int pm, pn, dpm;
    __device__ __forceinline__ bool next(int i, pg8::Unit& o) const { if (i >= 3) return false; o.pm = pm + i * dpm; o.pn = pn + 4 * i; return true; }
    __device__ __forceinline__ void a_ready(const pg8::Unit&) const {}
    __device__ __forceinline__ void done(const pg8::Unit&) const {}
};
struct OneUnit {
    pg8::Unit u;
    __device__ __forceinline__ bool next(int i, pg8::Unit& o) const { if (i != 0) return false; o = u; return true; }
    __device__ __forceinline__ void a_ready(const pg8::Unit&) const {}
    __device__ __forceinline__ void done(const pg8::Unit&) const {}
};
struct FOut {
    struct L { u32x4 g; f32x4 a, b; };
    const GAS float* res; const GAS bf16_t* resb; GAS bf16_t* dst;
    __device__ __forceinline__ void begin() const {}
    __device__ __forceinline__ L load(int row, int c0) const {
        const size_t o = (size_t)row * DM + c0; L l; l.g = (u32x4){0u, 0u, 0u, 0u}; l.a = (f32x4){0.f, 0.f, 0.f, 0.f}; l.b = l.a;
        if (res) { l.a = *(const GAS f32x4*)(res + o); l.b = *(const GAS f32x4*)(res + o + 4); } else l.g = *(const GAS u32x4*)(resb + o);
        return l;
    }
    __device__ __forceinline__ void apply(int row, int c0, f32x4 v0, f32x4 v1, const L& l) const {
        const size_t o = (size_t)row * DM + c0;
        f32x4 a = l.a, b = l.b;
        if (!res) { const u32x4 g = l.g; a = (f32x4){bflo(g.x), bfhi(g.x), bflo(g.y), bfhi(g.y)}; b = (f32x4){bflo(g.z), bfhi(g.z), bflo(g.w), bfhi(g.w)}; }
        *(GAS u32x4*)(dst + o) = pack8(a * ALPHA + v0, b * ALPHA + v1);
    }
};
struct FFf1 {
    typedef NoLoad L;
    GAS bf16_t* HF; GAS bf16_t* PG;
    __device__ __forceinline__ void begin() const {}
    __device__ __forceinline__ L load(int, int) const { return L{}; }
    __device__ __forceinline__ void apply(int row, int c0, f32x4 v0, f32x4 v1, const L&) const {
        if (c0 < DFF) {
#pragma unroll
            for (int i = 0; i < 4; ++i) { const float a = fmaxf(v0[i], 0.f), b = fmaxf(v1[i], 0.f); v0[i] = a * a; v1[i] = b * b; }
            *(GAS u32x4*)(HF + (size_t)row * HFP + 256 + c0) = pack8(v0, v1);
        } else {
#pragma unroll
            for (int i = 0; i < 4; ++i) { v0[i] = sigm(v0[i]); v1[i] = sigm(v1[i]); }
            *(GAS u32x4*)(PG + (size_t)row * DM + (c0 - DFF)) = pack8(v0, v1);
        }
    }
};
struct FPle {
    struct L { u32x4 g; };
    GAS bf16_t* PG;
    __device__ __forceinline__ void begin() const {}
    __device__ __forceinline__ L load(int row, int c0) const { L l; l.g = *(const GAS u32x4*)(PG + (size_t)row * DM + c0); return l; }
    __device__ __forceinline__ void apply(int row, int c0, f32x4 v0, f32x4 v1, const L& l) const {
        const size_t o = (size_t)row * DM + c0; const u32x4 g = l.g;
        v0[0] *= bflo(g.x); v0[1] *= bfhi(g.x); v0[2] *= bflo(g.y); v0[3] *= bfhi(g.y);
        v1[0] *= bflo(g.z); v1[1] *= bfhi(g.z); v1[2] *= bflo(g.w); v1[3] *= bfhi(g.w);
        *(GAS u32x4*)(PG + o) = pack8(v0, v1);
    }
};
struct FFf2 {
    struct L { u32x4 g, x; };
    const GAS bf16_t* XB; GAS bf16_t* PG;
    __device__ __forceinline__ void begin() const { l1_inv(); }
    __device__ __forceinline__ L load(int row, int c0) const { const size_t o = (size_t)row * DM + c0; L l; l.g = *(const GAS u32x4*)(PG + o); l.x = *(const GAS u32x4*)(XB + o); return l; }
    __device__ __forceinline__ void apply(int row, int c0, f32x4 v0, f32x4 v1, const L& l) const {
        const size_t o = (size_t)row * DM + c0;
        const u32x4 g = l.g, x = l.x;
        f32x4 r0 = v0, r1 = v1;
        r0[0] += bflo(g.x) + ALPHA * bflo(x.x); r0[1] += bfhi(g.x) + ALPHA * bfhi(x.x); r0[2] += bflo(g.y) + ALPHA * bflo(x.y); r0[3] += bfhi(g.y) + ALPHA * bfhi(x.y);
        r1[0] += bflo(g.z) + ALPHA * bflo(x.z); r1[1] += bfhi(g.z) + ALPHA * bfhi(x.z); r1[2] += bflo(g.w) + ALPHA * bflo(x.w); r1[3] += bfhi(g.w) + ALPHA * bfhi(x.w);
        *(GAS u32x4*)(PG + o) = pack8(r0, r1);
    }
};
template <class F> __device__ __forceinline__ void run_gemm(LAS unsigned char* lds, const bf16_t* A, const bf16_t* Bt, int M, int N, int K, const F& f) {
    asm volatile("" : "+s"(K), "+s"(N), "+s"(M));
    pg8::Gemm g{A, Bt, M, N, K}; pg8::StaticOrder S; S.init(M, N, (int)gridDim.x, (int)blockIdx.x);
    EpiF<F> E{f};
    pg8::gemm_phase<EpiF<F>, pg8::StaticOrder, true, true>(lds, g, S, E);
}
template <class F> __device__ __forceinline__ void run_gemm_one(LAS unsigned char* lds, const bf16_t* A, const bf16_t* Bt, int M, int N, int K, pg8::Unit u, const F& f) {
    asm volatile("" : "+s"(K), "+s"(N), "+s"(M));
    pg8::Gemm g{A, Bt, M, N, K}; OneUnit S{u};
    EpiF<F> E{f};
    pg8::gemm_phase<EpiF<F>, OneUnit, true, true>(lds, g, S, E);
}
template <class F> __device__ __forceinline__ void run_gemm_tri(LAS unsigned char* lds, const bf16_t* A, const bf16_t* Bt, int M, int N, int K, TriUnit S, const F& f) {
    asm volatile("" : "+s"(K), "+s"(N), "+s"(M));
    pg8::Gemm g{A, Bt, M, N, K};
    EpiF<F> E{f};
    pg8::gemm_phase<EpiF<F>, TriUnit, true, true>(lds, g, S, E);
}
__device__ __forceinline__ void run_gemm_ff2(LAS unsigned char* lds, const bf16_t* A, const bf16_t* Bt, int M, int N, int K, const EpiFf2& E) {
    asm volatile("" : "+s"(K), "+s"(N), "+s"(M));
    pg8::Gemm g{A, Bt, M, N, K}; pg8::StaticOrder S; S.init(M, N, (int)gridDim.x, (int)blockIdx.x);
    pg8::gemm_phase<EpiFf2, pg8::StaticOrder, true, true>(lds, g, S, E);
}
__device__ __forceinline__ void run_gemm_chain(LAS unsigned char* lds, const bf16_t* A, const bf16_t* Bt, int M, int N, int K, TriUnit S, const EpiUpChain& E) {
    asm volatile("" : "+s"(K), "+s"(N), "+s"(M));
    pg8::Gemm g{A, Bt, M, N, K};
    pg8::gemm_phase<EpiUpChain, TriUnit, true, true>(lds, g, S, E);
}
__device__ __forceinline__ int win_src(int n) {
    if (n < 1152) return n;
    if (n < 2112) { const int e = n - 1152; return 1158 + e; }
    if (n < 2432) { const int e = n - 2112, hh = e >> 6, p = e & 63; return 2118 + hh * 64 + (p >> 1) + 32 * (p & 1); }
    if (n < 2496) { const int p = n - 2432; return 2438 + (p >> 1) + 32 * (p & 1); }
    if (n < 2560) return 2502 + (n - 2496);
    if (n < 3072) { const int e = n - 2560, hh = e >> 6, p = e & 63; return 2566 + hh * 64 + (p >> 1) + 32 * (p & 1); }
    if (n < 3136) { const int p = n - 3072; return 3078 + (p >> 1) + 32 * (p & 1); }
    if (n < 3142) return 1152 + (n - 3136);
    if (n < 3144) return -1;
    if (n < 3152) return 3142 + (n - 3144);
    return -1;
}
struct GWin { const float* W; __device__ __forceinline__ float operator()(int k, int n) const { const int s = win_src(n); return s < 0 ? 0.f : W[(size_t)k * CIN + s]; } };
struct GWg { const float* W; int j; __device__ __forceinline__ float operator()(int k, int n) const { return W[(size_t)k * CIN + 3150 + j * DM + n]; } };
struct GUp { const float* W; int kj; __device__ __forceinline__ float operator()(int k, int n) const { return k < kj ? W[(size_t)k * DM + n] : 0.f; } };
struct GPlain { const float* W; int pitch; __device__ __forceinline__ float operator()(int k, int n) const { return W[(size_t)k * pitch + n]; } };
struct GCat { const float* Wp; const float* Wf; __device__ __forceinline__ float operator()(int k, int n) const { return k < 256 ? Wp[(size_t)k * DM + n] : Wf[(size_t)(k - 256) * DM + n]; } };
struct GFf1 { const float* Wf; const float* Wp; __device__ __forceinline__ float operator()(int k, int n) const { return n < DFF ? Wf[(size_t)k * DFF + n] : Wp[(size_t)k * DM + (n - DFF)]; } };
template <class G> __device__ __forceinline__ void tr_item(const G& get, int K, int N, bf16_t* WT, LAS float* scr, int item, int lane) {
    const int nblk = N / 32, kb = item / nblk, nb = item % nblk, k0 = 64 * kb, n0 = 32 * nb;
#pragma unroll 8
    for (int i = 0; i < 32; ++i) { const int kk = 2 * i + (lane >> 5); scr[kk * 33 + (lane & 31)] = get(k0 + kk, n0 + (lane & 31)); }
    asm volatile("s_waitcnt lgkmcnt(0)" ::: "memory");
    const int c = lane & 7;
#pragma unroll
    for (int j = 0; j < 4; ++j) { const int n = (lane >> 3) + 8 * j; const LAS float* s = scr + (8 * c) * 33 + n;
        u32x4 o; o.x = cvtpk(s[0 * 33], s[1 * 33]); o.y = cvtpk(s[2 * 33], s[3 * 33]); o.z = cvtpk(s[4 * 33], s[5 * 33]); o.w = cvtpk(s[6 * 33], s[7 * 33]);
        *(u32x4*)(WT + (size_t)(n0 + n) * K + k0 + 8 * c) = o; }
    asm volatile("s_waitcnt lgkmcnt(0)" ::: "memory");
}
__device__ __forceinline__ void sincos_d(double x, double& s, double& c) {
    const double k = rint(x * 0.63661977236758134308);
    const double r = fma(-k, 6.123233995736766e-17, fma(-k, 1.5707963267948966, x));
    const double r2 = r * r;
    const double sp = r * (1.0 + r2 * (-1.0 / 6 + r2 * (1.0 / 120 + r2 * (-1.0 / 5040 + r2 * (1.0 / 362880 + r2 * (-1.0 / 39916800 + r2 * (1.0 / 6227020800.0)))))));
    const double cp = 1.0 + r2 * (-0.5 + r2 * (1.0 / 24 + r2 * (-1.0 / 720 + r2 * (1.0 / 40320 + r2 * (-1.0 / 3628800 + r2 * (1.0 / 479001600 + r2 * (-1.0 / 87178291200.0)))))));
    const int q = ((int)k) & 3;
    s = (q == 0) ? sp : (q == 1) ? cp : (q == 2) ? -sp : -cp;
    c = (q == 0) ? cp : (q == 1) ? -sp : (q == 2) ? -cp : sp;
}
struct Args { const float* in[16]; float* out; unsigned char* ws; };

__device__ __forceinline__ void prologue(LAS unsigned char* lds, const Args& a) {
    const int tid = opaque_tid(), lane = tid & 63, wid = __builtin_amdgcn_readfirstlane(tid >> 6);
    LAS float* scr = (LAS float*)(lds + wid * 16384);
    const int gw = blockIdx.x * 8 + wid, NGW = gridDim.x * 8;
    unsigned char* ws = a.ws;
    constexpr int I_IN = 16 * (NIN / 32), I_G = 3 * 512, I_UP = 3 * 192, I_OUT = 512, I_FF1 = 16 * (NFF1 / 32), I_FF2 = (HFP / 64) * 32, I_PLE = 0;
    constexpr int I_LAYER = I_IN + I_G + I_UP + I_OUT + I_FF1 + I_FF2 + I_PLE;
    for (int it = gw; it < 2 * I_LAYER; it += NGW) {
        const int L = it / I_LAYER; int r = it % I_LAYER;
        unsigned char* wl = ws + WS_W + (size_t)L * W_LAYER;
        if (r < I_IN) { tr_item(GWin{a.in[2] + (size_t)L * DM * CIN}, DM, NIN, (bf16_t*)(wl + WO_IN), scr, r, lane); continue; } r -= I_IN;
        if (r < I_G) { const int j = r / 512; tr_item(GWg{a.in[2] + (size_t)L * DM * CIN, j}, DM, DM, (bf16_t*)(wl + WO_G) + (size_t)j * DM * DM, scr, r % 512, lane); continue; } r -= I_G;
        if (r < I_UP) { const int j = r / 192; const int kj = j == 0 ? 384 : 320; const float* src = a.in[4 + j] + (size_t)L * kj * DM;
            tr_item(GUp{src, kj}, OCW, DM, (bf16_t*)(wl + WO_UP) + (size_t)j * DM * OCW, scr, r % 192, lane); continue; } r -= I_UP;
        if (r < I_OUT) { tr_item(GPlain{a.in[7] + (size_t)L * DM * DM, DM}, DM, DM, (bf16_t*)(wl + WO_OUT), scr, r, lane); continue; } r -= I_OUT;
        if (r < I_FF1) { tr_item(GFf1{a.in[10] + (size_t)L * DM * DFF, a.in[13] + (size_t)L * DM * DM}, DM, NFF1, (bf16_t*)(wl + WO_FF1), scr, r, lane); continue; } r -= I_FF1;
        tr_item(GCat{a.in[12] + (size_t)L * 256 * DM, a.in[11] + (size_t)L * DFF * DM}, HFP, DM, (bf16_t*)(wl + WO_FF2), scr, r, lane);
    }
    const size_t gt = (size_t)blockIdx.x * 512 + tid, NT = (size_t)gridDim.x * 512;
    {
        const f32x4* x4 = (const f32x4*)a.in[0]; u32x4* xb = (u32x4*)(ws + WS_XB);
        for (size_t i = gt; i < (size_t)T_TOK * DM / 8; i += NT) xb[i] = pack8(x4[2 * i], x4[2 * i + 1]);
    }
    {
        bf16_t* oc = (bf16_t*)(ws + WS_OC);
        for (size_t i = gt; i < (size_t)2 * T_TOK * 8; i += NT) { const size_t j = i / ((size_t)T_TOK * 8), rr = i % ((size_t)T_TOK * 8), row = rr >> 3, ch = rr & 7;
            *(u32x4*)(oc + (1 + j) * OC_STRIDE + row * OCW + 320 + ch * 8) = (u32x4){0u, 0u, 0u, 0u}; }
    }
    {
        float* cs = (float*)(ws + WS_TRIG);
        for (size_t e = gt; e < (size_t)SEQ * 32; e += NT) { const int pos = (int)(e >> 5), i = (int)(e & 31);
            double inv = 1.0; for (int t = 0; t < i; ++t) inv *= 0.7498942093324559;
            const float ang = (float)pos * (float)inv; double s, c; sincos_d((double)ang, s, c);
            cs[2 * e] = (float)c; cs[2 * e + 1] = (float)s; }
    }
}

__device__ __forceinline__ int next_unit(unsigned* ctr, LAS unsigned* slot) {
    __syncthreads();
    if (opaque_tid() == 0) *slot = atomicAdd(ctr, 1u);
    __syncthreads();
    return __builtin_amdgcn_readfirstlane((int)*slot);
}
__device__ __forceinline__ bf16x8 packf8(const f32x16& x, int s) {
    u32x4 w; w.x = cvtpk(x[8 * s], x[8 * s + 1]); w.y = cvtpk(x[8 * s + 2], x[8 * s + 3]); w.z = cvtpk(x[8 * s + 4], x[8 * s + 5]); w.w = cvtpk(x[8 * s + 6], x[8 * s + 7]);
    return __builtin_bit_cast(bf16x8, w);
}
template <int MODE>
__device__ __forceinline__ void attn_unit(LAS unsigned char* lds, const GAS bf16_t* __restrict__ HA, int b, int qb, int qcol, int kcol, int vcol,
                                          GAS bf16_t* __restrict__ O, int ocol, const GAS float* __restrict__ FL, float bfv, const GAS unsigned long long* __restrict__ MB) {
    const int tid = opaque_tid(), lane = tid & 63, r32 = lane & 31, hi = lane >> 5; const int wid = __builtin_amdgcn_readfirstlane(tid >> 6);
    LAS float* cbuf = (LAS float*)(lds + 36864); LAS float* wt = (LAS float*)(lds + 45056); LAS unsigned* flags = (LAS unsigned*)(lds + (MODE == 1 ? 92160 + 64 : 45088));
    const size_t rowbase = (size_t)b * SEQ; const int qw = qb * 256 + wid * 32, q = qw + r32; const int ntiles = 4 * (qb + 1), td = qw >> 6;
    float cq = 0.f;
    if (MODE == 0) {
        float lf[4];
#pragma unroll
        for (int i = 0; i < 4; ++i) { const float x = FL[(rowbase + 4 * tid + i) * 8] + bfv; lf[i] = (fminf(x, 0.f) - __logf(1.f + __expf(-fabsf(x)))) * L2E; }
        const float s1 = lf[0], s2 = s1 + lf[1], s3 = s2 + lf[2], s4 = s3 + lf[3];
        float v = s4;
#pragma unroll
        for (int off = 1; off < 64; off <<= 1) { const float n = __shfl_up(v, off); if (lane >= off) v += n; }
        if (lane == 63) wt[wid] = v;
        __syncthreads();
        float base = 0.f;
#pragma unroll
        for (int w = 0; w < 8; ++w) { const float x = wt[w]; if (w < wid) base += x; }
        const float ex = base + v - s4;
        *(LAS f32x4*)(cbuf + 4 * tid) = (f32x4){ex + s1, ex + s2, ex + s3, ex + s4};
        __syncthreads();
        cq = cbuf[q];
    }
    if (MODE == 1) { if (tid < 8) flags[tid] = 0u; }
    bf16x8 qr[4];
    { const GAS bf16_t* qp = HA + (rowbase + q) * LDH + qcol + hi * 8;
#pragma unroll
      for (int d0 = 0; d0 < 4; ++d0) qr[d0] = *(const GAS bf16x8*)(qp + d0 * 16); }
    bf16x8 T0, T1, ONES;
    if (MODE == 1) {
#pragma unroll
        for (int j = 0; j < 8; ++j) { const int kk = 8 * (j >> 2) + 4 * hi + (j & 3); T0[j] = (kk > r32) ? (short)0x3F80 : (short)0; T1[j] = (16 + kk > r32) ? (short)0x3F80 : (short)0; ONES[j] = (short)0x3F80; }
    }
    LAS unsigned long long* mlds = (LAS unsigned long long*)(lds + 45568) + (wid * 32 + r32) * 33;
    if (MODE == 2) {
        const GAS unsigned long long* mbp = MB + (rowbase + q) * 32 + hi * 16;
        u32x4 mw[8];
#pragma unroll
        for (int i = 0; i < 8; ++i) mw[i] = *(const GAS u32x4*)(mbp + 2 * i);
#pragma unroll
        for (int i = 0; i < 8; ++i) { mlds[hi * 16 + 2 * i] = ((unsigned long long)mw[i].y << 32) | mw[i].x; mlds[hi * 16 + 2 * i + 1] = ((unsigned long long)mw[i].w << 32) | mw[i].z; }
    }
    f32x16 zero16;
#pragma unroll
    for (int i = 0; i < 16; ++i) zero16[i] = 0.f;
    f32x16 o0 = zero16, o1 = zero16;
    float m = 0.f, l = 0.f, R = 0.f; bool uns = true;
    const int skr = tid >> 3, sch = tid & 7;
    const GAS bf16_t* kg = HA + (rowbase + skr) * LDH + kcol + sch * 8;
    const GAS bf16_t* vg = HA + (rowbase + skr) * LDH + vcol + sch * 8;
    const int t_first = (MODE == 1) ? ntiles - 1 : 0;
    u32x4 kreg = *(const GAS u32x4*)(kg + (size_t)t_first * 64 * LDH), vreg = *(const GAS u32x4*)(vg + (size_t)t_first * 64 * LDH);
#define STAGE_TILE(bufi, KR, VR) do { LAS bf16_t* Ks_ = (LAS bf16_t*)(lds + (bufi) * 18432); LAS bf16_t* Vs_ = (LAS bf16_t*)(lds + (bufi) * 18432 + 9216); \
        *(LAS u32x4*)(Ks_ + skr * 72 + sch * 8) = KR; *(LAS u32x4*)(Vs_ + skr * 72 + sch * 8) = VR; } while (0)
#define VTR(p) __builtin_bit_cast(s16x4, __builtin_amdgcn_ds_read_tr16_b64_v4i16((LAS v4i16_t*)(p)))
#define VFRAG(dblk, kb) __builtin_shufflevector(VTR(vp + 16 * (kb) * 72 + 32 * (dblk)), VTR(vp + (16 * (kb) + 8) * 72 + 32 * (dblk)), 0, 1, 2, 3, 4, 5, 6, 7)
#define COMPUTE_TILE(T_, CUR_) do { const int t = (T_); const int cur = (CUR_); \
        if (t <= td) { \
            const LAS bf16_t* Ks = (const LAS bf16_t*)(lds + cur * 18432); const LAS bf16_t* Vt = (const LAS bf16_t*)(lds + cur * 18432 + 9216); \
            unsigned long long bits = 0ull; \
            if (MODE == 2) bits = mlds[t]; \
            const float init = (MODE == 1) ? 0.f : cq - m; \
            const int kbase = t * 64 + 4 * hi; \
            f32x16 p0, p1; \
            if (MODE == 0) { \
_Pragma("unroll") \
                for (int g = 0; g < 4; ++g) { \
                    const f32x4 c0 = *(const LAS f32x4*)(cbuf + kbase + 8 * g), c1 = *(const LAS f32x4*)(cbuf + kbase + 32 + 8 * g); \
_Pragma("unroll") \
                    for (int i = 0; i < 4; ++i) { p0[4 * g + i] = init - c0[i]; p1[4 * g + i] = init - c1[i]; } \
                } \
            } else if (MODE == 2) { \
                const unsigned blo = (unsigned)(bits >> (4 * hi)), bhi = (unsigned)(bits >> (32 + 4 * hi)); \
_Pragma("unroll") \
                for (int r = 0; r < 16; ++r) { const int ix = (r & 3) + 8 * (r >> 2); p0[r] = ((blo >> ix) & 1u) ? init : NEGF; p1[r] = ((bhi >> ix) & 1u) ? init : NEGF; } \
            } else { \
_Pragma("unroll") \
                for (int r = 0; r < 16; ++r) { p0[r] = 0.f; p1[r] = 0.f; } \
            } \
            { const LAS bf16_t* kp = Ks + r32 * 72 + hi * 8; \
_Pragma("unroll") \
              for (int d0 = 0; d0 < 4; ++d0) { \
                  const bf16x8 k0 = *(const LAS bf16x8*)(kp + d0 * 16), k1 = *(const LAS bf16x8*)(kp + 32 * 72 + d0 * 16); \
                  p0 = MFMA32(k0, qr[d0], p0); p1 = MFMA32(k1, qr[d0], p1); \
              } } \
            if (MODE == 1) { \
                f32x16 lb0, lb1; \
_Pragma("unroll") \
                for (int r = 0; r < 16; ++r) { \
                    const int k = kbase + (r & 3) + 8 * (r >> 2); \
                    { const float z = p0[r], sp = fmaxf(z, 0.f) + __builtin_amdgcn_logf(1.f + ex2(-fabsf(z))); float L = -sp, lb = z - sp; if (t == td && k >= q) { L = 0.f; lb = NEGF; } p0[r] = L; lb0[r] = lb; } \
                    { const float z = p1[r], sp = fmaxf(z, 0.f) + __builtin_amdgcn_logf(1.f + ex2(-fabsf(z))); float L = -sp, lb = z - sp; if (t == td && k + 32 >= q) { L = 0.f; lb = NEGF; } p1[r] = L; lb1[r] = lb; } \
                } \
                const bf16x8 L00 = packf8(p0, 0), L01 = packf8(p0, 1), L10 = packf8(p1, 0), L11 = packf8(p1, 1); \
                const f32x16 X1 = MFMA32(ONES, L10, MFMA32(ONES, L11, zero16)); \
                const f32x16 a0 = MFMA32(T0, L00, MFMA32(T1, L01, X1)); \
                const f32x16 a1 = MFMA32(T0, L10, MFMA32(T1, L11, zero16)); \
                const f32x16 tt = MFMA32(ONES, L00, MFMA32(ONES, L01, X1)); \
_Pragma("unroll") \
                for (int r = 0; r < 16; ++r) { p0[r] = ex2(lb0[r] + a0[r] + R); p1[r] = ex2(lb1[r] + a1[r] + R); } \
                R += tt[0]; \
            } else { \
                float mx = NEGF; \
                if (MODE == 0 && t == td) { \
_Pragma("unroll") \
                    for (int r = 0; r < 16; ++r) { const int k = kbase + (r & 3) + 8 * (r >> 2); if (k > q) p0[r] = NEGF; if (k + 32 > q) p1[r] = NEGF; } \
                } \
_Pragma("unroll") \
                for (int r = 0; r < 16; ++r) mx = fmaxf(mx, fmaxf(p0[r], p1[r])); \
                mx = fmaxf(mx, __shfl_xor(mx, 32)); \
 \
                float dl = 0.f, f = 1.f; \
                if (uns) { if (mx > -1e29f) { dl = mx; uns = false; } } \
                else if (mx > 8.f) { dl = mx; f = ex2(-dl); } \
                if (__any(dl != 0.f)) { \
                    m += dl; l *= f; \
_Pragma("unroll") \
                    for (int r = 0; r < 16; ++r) { o0[r] *= f; o1[r] *= f; p0[r] -= dl; p1[r] -= dl; } \
                } \
                float ps = 0.f; \
_Pragma("unroll") \
                for (int r = 0; r < 16; ++r) { p0[r] = ex2(p0[r]); p1[r] = ex2(p1[r]); ps += p0[r] + p1[r]; } \
                l += ps; \
            } \
 \
            const bf16x8 pb0 = packf8(p0, 0), pb1 = packf8(p0, 1), pb2 = packf8(p1, 0), pb3 = packf8(p1, 1); \
 \
            const LAS bf16_t* vp = Vt + (4 * hi + ((lane & 15) >> 2)) * 72 + 16 * ((lane >> 4) & 1) + 4 * (lane & 3); \
            o0 = MFMA32(VFRAG(0, 0), pb0, o0); o0 = MFMA32(VFRAG(0, 1), pb1, o0); o0 = MFMA32(VFRAG(0, 2), pb2, o0); o0 = MFMA32(VFRAG(0, 3), pb3, o0); \
            o1 = MFMA32(VFRAG(1, 0), pb0, o1); o1 = MFMA32(VFRAG(1, 1), pb1, o1); o1 = MFMA32(VFRAG(1, 2), pb2, o1); o1 = MFMA32(VFRAG(1, 3), pb3, o1); \
            if (MODE == 1) { if (__all(R < -160.f) && lane == 0) flags[wid] = 1u; } \
        } \
    } while (0)
#define LOAD_TILE(KR, VR, tl) do { KR = *(const GAS u32x4*)(kg + (size_t)(tl) * 64 * LDH); VR = *(const GAS u32x4*)(vg + (size_t)(tl) * 64 * LDH); } while (0)
#define TILE_OF(it_) ((MODE == 1) ? ntiles - 1 - (it_) : (it_))
    if (MODE == 1) {
        u32x4 k1, v1, k2, v2, k3, v3;
        LOAD_TILE(k1, v1, ntiles - 2); LOAD_TILE(k2, v2, ntiles - 3); LOAD_TILE(k3, v3, ntiles - 4);
        STAGE_TILE((ntiles - 1) % 5, kreg, vreg); STAGE_TILE((ntiles - 2) % 5, k1, v1); STAGE_TILE((ntiles - 3) % 5, k2, v2); STAGE_TILE((ntiles - 4) % 5, k3, v3);
        __syncthreads();
        for (int i = 0; i < ntiles; ++i) {
            const int tnew = ntiles - 5 - i;
            if (tnew >= 0) LOAD_TILE(kreg, vreg, tnew);
            const int tw = td - i;
            if (tw >= 0) COMPUTE_TILE(tw, tw % 5);
            if (tnew >= 0) STAGE_TILE(tnew % 5, kreg, vreg);
            __syncthreads();
            { const u32x4 fa = *(const LAS u32x4*)flags, fb = *(const LAS u32x4*)(flags + 4); if ((fa.x & fa.y & fa.z & fa.w & fb.x & fb.y & fb.z & fb.w) != 0u) break; }
        }
    } else {
    u32x4 kB, vB;
    STAGE_TILE(0, kreg, vreg);
    LOAD_TILE(kB, vB, TILE_OF(1));
    __syncthreads();
    bool stop = false;
    for (int it = 0; it < ntiles && !stop; it += 2) {
        LOAD_TILE(kreg, vreg, TILE_OF(min(it + 2, ntiles - 1)));
        COMPUTE_TILE(TILE_OF(it), 0);
        STAGE_TILE(1, kB, vB);
        __syncthreads();
        if (MODE == 1) { const u32x4 fa = *(const LAS u32x4*)flags, fb = *(const LAS u32x4*)(flags + 4); if ((fa.x & fa.y & fa.z & fa.w & fb.x & fb.y & fb.z & fb.w) != 0u) break; }
        LOAD_TILE(kB, vB, TILE_OF(min(it + 3, ntiles - 1)));
        COMPUTE_TILE(TILE_OF(it + 1), 1);
        STAGE_TILE(0, kreg, vreg);
        __syncthreads();
        if (MODE == 1) { const u32x4 fa = *(const LAS u32x4*)flags, fb = *(const LAS u32x4*)(flags + 4); if ((fa.x & fa.y & fa.z & fa.w & fb.x & fb.y & fb.z & fb.w) != 0u) stop = true; }
    }
    }
#undef LOAD_TILE
#undef TILE_OF
#undef COMPUTE_TILE
#undef VTR
#undef VFRAG
#undef STAGE_TILE
    float inv = 1.f;
    if (MODE != 1) { const float lt = l + __shfl_xor(l, 32); inv = 1.f / lt; }
    GAS bf16_t* op = O + (rowbase + q) * OCW + ocol + 4 * hi;
#pragma unroll
    for (int g = 0; g < 4; ++g) {
        u32x2 w0, w1;
        w0.x = cvtpk(o0[4 * g] * inv, o0[4 * g + 1] * inv); w0.y = cvtpk(o0[4 * g + 2] * inv, o0[4 * g + 3] * inv);
        w1.x = cvtpk(o1[4 * g] * inv, o1[4 * g + 1] * inv); w1.y = cvtpk(o1[4 * g + 2] * inv, o1[4 * g + 3] * inv);
        *(GAS u32x2*)(op + 8 * g) = w0; *(GAS u32x2*)(op + 32 + 8 * g) = w1;
    }
}

__device__ __forceinline__ unsigned skey_of(float f) { const unsigned u = __float_as_uint(f); return u ^ ((unsigned)((int)u >> 31) | 0x80000000u); }
template <int NJ>
__device__ __forceinline__ void select_rows(const GAS float* sr0, GAS unsigned long long* mb0, LAS unsigned* hist, LAS unsigned* kbuf, int ntl, int lane) {
    unsigned vm = ntl >= 32 ? 0xffffffffu : ((1u << ntl) - 1u);
    asm volatile("" : "+v"(vm));
#pragma unroll 1
    for (int rr = 0; rr < 8; ++rr) {
        const GAS float* srow = sr0 + (size_t)rr * SEQ;
        float fv[NJ];
#pragma unroll
        for (int j = 0; j < NJ; ++j) fv[j] = srow[64 * j];
        { unsigned z = 0u; asm volatile("" : "+v"(z));
          *(LAS u32x4*)(hist + 4 * lane) = (u32x4){z, z, z, z}; if (lane < 2) hist[256 + lane] = z; }
        __builtin_amdgcn_wave_barrier();
        unsigned key[NJ];
#pragma unroll
        for (int j = 0; j < NJ; ++j) {
            const float f = fv[j]; const bool ok = (vm >> j) & 1u;
            key[j] = ok ? skey_of(f) : 0u;
            const int bk = min(max((int)floorf(f + f) + 128, 0), 255);
            __hip_atomic_fetch_add(hist + (ok ? bk : 256), 1u, __ATOMIC_RELAXED, __HIP_MEMORY_SCOPE_WORKGROUP);
        }
        __builtin_amdgcn_wave_barrier();
        asm volatile("s_waitcnt lgkmcnt(0)" ::: "memory");
        unsigned B, rem, C;
        {
            const u32x4 hv = *(const LAS u32x4*)(hist + 4 * lane);
            const unsigned s4 = hv.x + hv.y + hv.z + hv.w;
            unsigned S = s4;
#pragma unroll
            for (int off = 1; off < 64; off <<= 1) { const unsigned n = __shfl_down(S, off); if (lane + off < 64) S += n; }
            const unsigned excl = S - s4;
            const bool mine = (excl < 256u) && (256u <= S);
            unsigned dl, above, cnt, c = excl;
            if (c + hv.w >= 256u) { dl = 3; above = c; cnt = hv.w; } else { c += hv.w; if (c + hv.z >= 256u) { dl = 2; above = c; cnt = hv.z; } else { c += hv.z; if (c + hv.y >= 256u) { dl = 1; above = c; cnt = hv.y; } else { c += hv.y; dl = 0; above = c; cnt = hv.x; } } }
            const unsigned long long bm = __ballot(mine);
            const int src = bm ? (int)__builtin_ctzll(bm) : 0;
            B = (unsigned)__builtin_amdgcn_readlane((int)(4 * lane + dl), src);
            rem = 256u - (unsigned)__builtin_amdgcn_readlane((int)above, src);
            C = (unsigned)__builtin_amdgcn_readlane((int)cnt, src);
        }
        const unsigned klo = (B == 0u) ? 1u : skey_of((float)((int)B - 128) * 0.5f);
        const unsigned khi = (B == 255u) ? 0xffffffffu : skey_of((float)((int)B - 127) * 0.5f);
        const unsigned range = khi - klo;
        unsigned tau = 0u, remf = 0u, cnteq = 0u; bool generic = C > 64u;
        if (!generic) {
#pragma unroll
            for (int j = 0; j < NJ; ++j) {
                if ((key[j] - klo) < range) { const unsigned slot = __hip_atomic_fetch_add(hist + 257, 1u, __ATOMIC_RELAXED, __HIP_MEMORY_SCOPE_WORKGROUP); hist[258 + (slot & 63u)] = key[j]; }
            }
            __builtin_amdgcn_wave_barrier();
            asm volatile("s_waitcnt lgkmcnt(0)" ::: "memory");
            const bool have = (unsigned)lane < C;
            const unsigned mykey = have ? hist[258 + lane] : 0u;
            unsigned cgt = 0u;
            for (unsigned i = 0; i < C; ++i) { const unsigned o = (unsigned)__builtin_amdgcn_readlane((int)mykey, (int)i); cgt += (o > mykey) ? 1u : 0u; }
            unsigned t = (have && cgt < rem) ? mykey : 0xffffffffu;
#pragma unroll
            for (int o = 1; o < 64; o <<= 1) t = min(t, (unsigned)__shfl_xor((int)t, o));
            tau = t;
            const unsigned long long eqm = __ballot(have && mykey == tau);
            cnteq = (unsigned)__popcll(eqm);
            remf = rem - (unsigned)__builtin_amdgcn_readlane((int)cgt, eqm ? (int)__builtin_ctzll(eqm) : 0);
            generic = cnteq > remf;
        }
        unsigned mlo = 0u, mhi = 0u;
        if (!generic) {
#define WL1(J) if constexpr (J < NJ) { const unsigned long long w_ = __ballot(key[J] >= tau); const unsigned wl_ = (unsigned)w_, wh_ = (unsigned)(w_ >> 32); \
                asm volatile("s_nop 3\n\tv_writelane_b32 %0, %2, " #J "\n\tv_writelane_b32 %1, %3, " #J : "+v"(mlo), "+v"(mhi) : "s"(wl_), "s"(wh_)); }
            WL1(0) WL1(1) WL1(2) WL1(3) WL1(4) WL1(5) WL1(6) WL1(7) WL1(8) WL1(9) WL1(10) WL1(11) WL1(12) WL1(13) WL1(14) WL1(15)
            WL1(16) WL1(17) WL1(18) WL1(19) WL1(20) WL1(21) WL1(22) WL1(23) WL1(24) WL1(25) WL1(26) WL1(27) WL1(28) WL1(29) WL1(30) WL1(31)
#undef WL1
        } else {
#pragma unroll
            for (int j = 0; j < NJ; ++j) kbuf[64 * j + lane] = key[j];
            __builtin_amdgcn_wave_barrier();
            asm volatile("s_waitcnt lgkmcnt(0)" ::: "memory");
            unsigned pre = 0u;
            for (int bit = 31; bit >= 0; --bit) {
                const unsigned trial = pre | (1u << bit); unsigned cnt = 0u;
                for (int j = 0; j < NJ; ++j) cnt += (unsigned)__popcll(__ballot(kbuf[64 * j + lane] >= trial));
                if (cnt >= 256u) pre = trial;
            }
            unsigned cg = 0u;
            for (int j = 0; j < NJ; ++j) cg += (unsigned)__popcll(__ballot(kbuf[64 * j + lane] > pre));
            const unsigned take = 256u - cg; unsigned running = 0u;
            const unsigned long long lt_mask = (1ull << lane) - 1ull;
            for (int j = 0; j < NJ; ++j) {
                const unsigned k = kbuf[64 * j + lane];
                const bool eq = k == pre; const unsigned long long eqb = __ballot(eq);
                const unsigned before = running + (unsigned)__popcll(eqb & lt_mask);
                const unsigned long long w = __ballot(k > pre || (eq && before < take));
                running += (unsigned)__popcll(eqb);
                if (lane == j) { mlo = (unsigned)w; mhi = (unsigned)(w >> 32); }
            }
            __builtin_amdgcn_wave_barrier();
        }
        if (lane < 32) mb0[rr * 32 + lane] = ((unsigned long long)mhi << 32) | mlo;
    }
}

__device__ __forceinline__ unsigned sortable(float f) { unsigned u = __float_as_uint(f); if (u == 0x80000000u) u = 0u; return (u & 0x80000000u) ? ~u : (u | 0x80000000u); }
__device__ __forceinline__ void select_unit(LAS unsigned char* lds, const GAS bf16_t* __restrict__ HA, const GAS float* __restrict__ IW, int b, int qc, GAS float* __restrict__ scr, GAS unsigned long long* __restrict__ MB) {
    const int tid = opaque_tid(), lane = tid & 63, r32 = lane & 31, hi = lane >> 5; const int wid = __builtin_amdgcn_readfirstlane(tid >> 6);
    const size_t rowbase = (size_t)b * SEQ; const int ntl = qc + 1;
    if (ntl > 4) {
        const int c16 = lane & 15, lg = lane >> 4;
        const int ql = 16 * (wid & 3) + c16; const size_t qrow = rowbase + qc * 64 + ql;
        bf16x8 iqf[8][2]; float iwv[8];
        { const GAS bf16_t* qp = HA + qrow * LDH + 2560 + lg * 8;
#pragma unroll
          for (int hh = 0; hh < 8; ++hh) { iqf[hh][0] = *(const GAS bf16x8*)(qp + hh * 64); iqf[hh][1] = *(const GAS bf16x8*)(qp + hh * 64 + 32); }
          const f32x4 w0 = *(const GAS f32x4*)(IW + qrow * 8), w1 = *(const GAS f32x4*)(IW + qrow * 8 + 4);
          iwv[0] = w0[0]; iwv[1] = w0[1]; iwv[2] = w0[2]; iwv[3] = w0[3]; iwv[4] = w1[0]; iwv[5] = w1[1]; iwv[6] = w1[2]; iwv[7] = w1[3]; }
        const int nkb = 4 * ntl, nchunk = (ntl + 3) >> 2;
        const int srw = tid >> 3, sch = tid & 7;
        const GAS bf16_t* kgp = HA + (rowbase + srw) * LDH + 3072 + sch * 8;
        u32x4 kr[4];
#pragma unroll
        for (int i = 0; i < 4; ++i) if (i < ntl) kr[i] = *(const GAS u32x4*)(kgp + (size_t)(i * 64) * LDH);
#pragma unroll
        for (int i = 0; i < 4; ++i) if (i < ntl) *(LAS u32x4*)((LAS bf16_t*)lds + (i * 64 + srw) * 72 + sch * 8) = kr[i];
        __syncthreads();
        for (int c = 0; c < nchunk; ++c) {
            const int cur = c & 1; const bool more = c + 1 < nchunk;
            if (more) {
#pragma unroll
                for (int i = 0; i < 4; ++i) { const int tl = (c + 1) * 4 + i; if (tl < ntl) kr[i] = *(const GAS u32x4*)(kgp + (size_t)(tl * 64) * LDH); }
            }
            const LAS bf16_t* Kc = (const LAS bf16_t*)(lds + cur * 36864);
#pragma unroll 2
            for (int i = 0; i < 8; ++i) {
                const int kbl = (wid >> 2) + 2 * i, kb = c * 16 + kbl;
                if (kb < nkb) {
                    const LAS bf16_t* kp = Kc + (kbl * 16 + c16) * 72 + lg * 8;
                    const bf16x8 k0 = *(const LAS bf16x8*)kp, k1 = *(const LAS bf16x8*)(kp + 32);
                    f32x4 sc = (f32x4){0.f, 0.f, 0.f, 0.f};
#pragma unroll
                    for (int hh = 0; hh < 8; ++hh) {
                        f32x4 acc = __builtin_amdgcn_mfma_f32_16x16x32_bf16(k0, iqf[hh][0], (f32x4){0.f, 0.f, 0.f, 0.f}, 0, 0, 0);
                        acc = __builtin_amdgcn_mfma_f32_16x16x32_bf16(k1, iqf[hh][1], acc, 0, 0, 0);
#pragma unroll
                        for (int r = 0; r < 4; ++r) sc[r] += iwv[hh] * fmaxf(acc[r], 0.f);
                    }
                    *(GAS f32x4*)(scr + (size_t)ql * SEQ + kb * 16 + 4 * lg) = sc;
                }
            }
            if (more) {
#pragma unroll
                for (int i = 0; i < 4; ++i) { const int tl = (c + 1) * 4 + i; if (tl < ntl) *(LAS u32x4*)((LAS bf16_t*)(lds + (cur ^ 1) * 36864) + (i * 64 + srw) * 72 + sch * 8) = kr[i]; }
            }
            __syncthreads();
        }
    }
    asm volatile("s_waitcnt vmcnt(0)" ::: "memory");
    __syncthreads();
    l1_inv();
    GAS unsigned long long* mb0 = MB + (rowbase + qc * 64 + wid * 8) * 32;
    if (ntl <= 4) {
        for (int rr = 0; rr < 8; ++rr) if (lane < 32) mb0[rr * 32 + lane] = (lane < ntl) ? ~0ull : 0ull;
        return;
    }
    LAS unsigned* hist = (LAS unsigned*)(lds + 73728) + wid * 384;
    LAS unsigned* kbuf = (LAS unsigned*)lds + wid * 2048;
    const GAS float* sr0 = scr + (size_t)(wid * 8) * SEQ + lane;
    switch ((ntl + 7) >> 3) {
        case 1: select_rows<8>(sr0, mb0, hist, kbuf, ntl, lane); break;
        case 2: select_rows<16>(sr0, mb0, hist, kbuf, ntl, lane); break;
        case 3: select_rows<24>(sr0, mb0, hist, kbuf, ntl, lane); break;
        default: select_rows<32>(sr0, mb0, hist, kbuf, ntl, lane); break;
    }
}

__device__ __forceinline__ void ln_phase(const GAS bf16_t* Y, GAS bf16_t* XB, GAS float* OUT, const GAS float* g, const GAS float* bta, bool write_bf) {
    const int tid = opaque_tid(), lane = tid & 63, wid = tid >> 6;
    const int gw = blockIdx.x * 8 + wid, NGW = gridDim.x * 8;
    f32x4 gv[4], bv[4];
#pragma unroll
    for (int j = 0; j < 4; ++j) { gv[j] = *(const GAS f32x4*)(g + 4 * lane + 256 * j); bv[j] = *(const GAS f32x4*)(bta + 4 * lane + 256 * j); }
    constexpr int RB = 4;
    for (int row0 = gw; row0 < T_TOK; row0 += RB * NGW) {
        u32x2 w[RB][4];
#pragma unroll
        for (int r = 0; r < RB; ++r) { const int row = min(row0 + r * NGW, T_TOK - 1); const size_t ro = (size_t)row * DM + 4 * lane;
#pragma unroll
            for (int j = 0; j < 4; ++j) w[r][j] = __builtin_nontemporal_load((const GAS u32x2*)(Y + ro + 256 * j)); }
#pragma unroll
        for (int r = 0; r < RB; ++r) {
            const int row = row0 + r * NGW;
            if (row < T_TOK) {
                const size_t ro = (size_t)row * DM + 4 * lane;
                f32x4 v[4]; float s = 0.f;
#pragma unroll
                for (int j = 0; j < 4; ++j) { v[j] = (f32x4){bflo(w[r][j].x), bfhi(w[r][j].x), bflo(w[r][j].y), bfhi(w[r][j].y)}; s += (v[j][0] + v[j][1]) + (v[j][2] + v[j][3]); }
#pragma unroll
                for (int o = 1; o < 64; o <<= 1) s += __shfl_xor(s, o);
                const float mean = s * (1.f / DM); float s2 = 0.f;
#pragma unroll
                for (int j = 0; j < 4; ++j) { v[j] = v[j] - mean; s2 += (v[j][0] * v[j][0] + v[j][1] * v[j][1]) + (v[j][2] * v[j][2] + v[j][3] * v[j][3]); }
#pragma unroll
                for (int o = 1; o < 64; o <<= 1) s2 += __shfl_xor(s2, o);
                const float rstd = 1.f / sqrtf(s2 * (1.f / DM) + LN_EPS);
#pragma unroll
                for (int j = 0; j < 4; ++j) { const f32x4 y = v[j] * rstd * gv[j] + bv[j];
                    if (write_bf) { u32x2 o2; o2.x = cvtpk(y[0], y[1]); o2.y = cvtpk(y[2], y[3]); *(GAS u32x2*)(XB + ro + 256 * j) = o2; }
                    else __builtin_nontemporal_store(y, (GAS f32x4*)(OUT + ro + 256 * j)); }
            }
        }
    }
}

#define XB_TMO      128
#define XB_XCNT(j)  (256  + 64 * (j))
#define XB_XSUB(j)  (1280 + 64 * (j))
#define XB_XGEN(j)  (2304 + 64 * (j))
#define XB_TOP      3328
#define XB_TOPGEN   3392
#define XCD_BAR_WORDS 3456
#define XB_SPIN_CAP (1u << 18)

__device__ __forceinline__ unsigned xb_ld(unsigned* p)              { return __hip_atomic_load(p, __ATOMIC_RELAXED, __HIP_MEMORY_SCOPE_AGENT); }
__device__ __forceinline__ unsigned xb_add(unsigned* p, unsigned v) { return __hip_atomic_fetch_add(p, v, __ATOMIC_RELAXED, __HIP_MEMORY_SCOPE_AGENT); }
__device__ __forceinline__ unsigned xb_xcc_id() { return (unsigned)__builtin_amdgcn_s_getreg((3 << 11) | 20) & 0xFu; }
#define XB_SPIN(cond, bar) do { unsigned _sp = 0; while (cond) { __builtin_amdgcn_s_sleep(1); \
    if ((++_sp & 255u) == 0u) { if (xb_ld(&(bar)[XB_TMO])) break; if (_sp > XB_SPIN_CAP) { atomicAdd(&(bar)[XB_TMO], 1u); break; } } } } while (0)

struct XcdBarrier {
    unsigned* bar; unsigned x;
    volatile LAS unsigned* st;
};

__device__ __forceinline__ XcdBarrier xcd_barrier_post(unsigned* bar, volatile LAS unsigned* st) {
    XcdBarrier b; b.bar = bar; b.x = xb_xcc_id(); b.st = st;
    if (threadIdx.x == 0) (void)xb_add(&bar[XB_XCNT(b.x)], 1u);
    return b;
}
__device__ __forceinline__ void xcd_barrier_complete(unsigned* bar, unsigned x, unsigned& nloc, unsigned& nx) {
    const unsigned G = gridDim.x * gridDim.y * gridDim.z;
    unsigned sum, cnt, mine, sp = 0u;
    for (;;) {
        sum = 0u; cnt = 0u; mine = 0u;
#pragma unroll
        for (unsigned j = 0; j < 16; ++j) { const unsigned c = xb_ld(&bar[XB_XCNT(j)]); sum += c; cnt += (c > 0u) ? 1u : 0u; mine = (j == x) ? c : mine; }
        if (sum == G) break;
        __builtin_amdgcn_s_sleep(1);
        if ((++sp & 255u) == 0u) { if (xb_ld(&bar[XB_TMO])) break; if (sp > XB_SPIN_CAP) { atomicAdd(&bar[XB_TMO], 1u); break; } }
    }
    nloc = mine > 0u ? mine : 1u; nx = cnt > 0u ? cnt : 1u;
}

__device__ __forceinline__ void xcd_barrier(const XcdBarrier& b) {
    asm volatile("s_waitcnt vmcnt(0)" ::: "memory");
    __syncthreads();
    if (threadIdx.x == 0) {
        unsigned* bar = b.bar;
        __builtin_amdgcn_s_waitcnt(0);
        unsigned nloc = b.st[0], nx = b.st[1];
        if (nloc == 0u) { xcd_barrier_complete(bar, b.x, nloc, nx); b.st[0] = nloc; b.st[1] = nx; }
        const unsigned old = xb_add(&bar[XB_XSUB(b.x)], 1u);
        const unsigned gen = old / nloc;
        if (old + 1u == (gen + 1u) * nloc) {
            __builtin_amdgcn_fence(__ATOMIC_RELEASE, "agent");
            asm volatile("s_waitcnt vmcnt(0)" ::: "memory");
            const unsigned og = xb_add(&bar[XB_TOP], 1u);
            const unsigned tg = og / nx;
            if (og + 1u == (tg + 1u) * nx) xb_add(&bar[XB_TOPGEN], 1u);
            else XB_SPIN(xb_ld(&bar[XB_TOPGEN]) == tg, bar);
            __builtin_amdgcn_fence(__ATOMIC_ACQUIRE, "agent");
            xb_add(&bar[XB_XGEN(b.x)], 1u);
            asm volatile("s_waitcnt vmcnt(0)" ::: "memory");
        } else {
            XB_SPIN(xb_ld(&bar[XB_XGEN(b.x)]) == gen, bar);
            __builtin_amdgcn_fence(__ATOMIC_ACQUIRE, "agent");
            asm volatile("s_waitcnt vmcnt(0)" ::: "memory");
        }
    }
    __syncthreads();
}


__global__ void __launch_bounds__(512, 2) mega_fwd(Args a) {
    extern __shared__ __attribute__((aligned(16))) unsigned char lds_raw[];
    LAS unsigned char* lds = (LAS unsigned char*)lds_raw;
    LAS unsigned* slot = (LAS unsigned*)(lds + LDS_SLOT);
    cg::grid_group grid = cg::this_grid();
    volatile LAS unsigned* bst = (volatile LAS unsigned*)(lds + LDS_SLOT + 16);
    if (threadIdx.x < 2) bst[threadIdx.x] = 0u;
    __syncthreads();
    (void)xcd_barrier_post((unsigned*)(a.ws + WS_CTL) + 2048, bst);
#define GSYNC() do { XcdBarrier xb_; xb_.bar = (unsigned*)(KA->ws + WS_CTL) + 2048; xb_.x = xb_xcc_id(); xb_.st = (volatile LAS unsigned*)(lds + LDS_SLOT + 16); xcd_barrier(xb_); } while (0)
    const volatile __attribute__((address_space(4))) Args* KA = (const volatile __attribute__((address_space(4))) Args*)__builtin_amdgcn_kernarg_segment_ptr();
#define PH unsigned char* ws = KA->ws; int L = Lc; asm volatile("" : "+s"(ws), "+s"(L)); const unsigned char* wl = ws + WS_W + (size_t)L * W_LAYER; (void)wl
    prologue(lds, a);
    grid.sync();
    for (int Lc = 0; Lc < 2; ++Lc) {
        {
            PH;
            run_gemm(lds, (const bf16_t*)(ws + WS_XB), (const bf16_t*)(wl + WO_IN), T_TOK, NIN, DM, FIn{(GAS bf16_t*)(ws + WS_HA), (GAS float*)(ws + WS_FL), (GAS float*)(ws + WS_IW), (const GAS float*)(ws + WS_TRIG)});
        }
        GSYNC();
        {
            PH;
            unsigned* ctr = (unsigned*)(ws + WS_CTL) + 64 * (2 * L);
            const GAS float* bfg = (const GAS float*)KA->in[3] + L * 6;
            const GAS bf16_t* HA = (const GAS bf16_t*)(ws + WS_HA); const GAS float* FL = (const GAS float*)(ws + WS_FL); const GAS float* IW = (const GAS float*)(ws + WS_IW);
            GAS bf16_t* OC = (GAS bf16_t*)(ws + WS_OC); GAS unsigned long long* MB = (GAS unsigned long long*)(ws + WS_MB);
            GAS float* scr = (GAS float*)(ws + WS_SCR) + (size_t)blockIdx.x * 64 * SEQ;
            for (;;) {
                const int u = next_unit(ctr, slot); if (u >= 3840) break;
                const int lev = 7 - u / 480, rem = u % 480;
                if (rem < 192) { const int b = rem / 6, h = rem % 6; attn_unit<0>(lds, HA, b, lev, h * 64, 384 + h * 64, 768 + h * 64, OC, h * 64, FL + h, bfg[h], MB); }
                else if (rem < 352) { const int e = rem - 192, b = e / 5, h = e % 5; attn_unit<1>(lds, HA, b, lev, 1152 + h * 64, 1472 + h * 64, 1792 + h * 64, OC + OC_STRIDE, h * 64, FL, 0.f, MB); }
                else { const int s = rem - 352, qc = 4 * lev + 3 - (s >> 5), b = s & 31; select_unit(lds, HA, IW, b, qc, scr, MB); }
            }
        }
        GSYNC();
        {
            PH;
            unsigned* ctr = (unsigned*)(ws + WS_CTL) + 64 * (2 * L + 1);
            const GAS bf16_t* HA = (const GAS bf16_t*)(ws + WS_HA); GAS bf16_t* OC = (GAS bf16_t*)(ws + WS_OC); const GAS unsigned long long* MB = (const GAS unsigned long long*)(ws + WS_MB);
            for (;;) {
                const int u = next_unit(ctr, slot); if (u >= 1280) break;
                const int qb = 7 - u / 160, e = u % 160, b = e / 5, h = e % 5;
                attn_unit<2>(lds, HA, b, qb, 2112 + h * 64, 2432, 2496, OC + 2 * OC_STRIDE, h * 64, (const GAS float*)nullptr, 0.f, MB);
            }
        }
        GSYNC();
        for (int ui = 0; ui < 64; ++ui) {
            pg8::Unit u;
            { pg8::StaticOrder S; S.init(T_TOK, DM, (int)gridDim.x, (int)blockIdx.x); if (!S.next(ui, u)) break; }
            { PH;
              GAS unsigned char* Gt = (GAS unsigned char*)(ws + WS_MF + (size_t)blockIdx.x * 393216);
              run_gemm_tri(lds, (const bf16_t*)(ws + WS_XB), (const bf16_t*)(wl + WO_G), T_TOK, 3 * DM, DM, TriUnit{u.pm, u.pn, 0}, FGateT3{Gt, 256 * u.pm, 256 * u.pn}); }
            { PH;
              GAS unsigned char* Gt = (GAS unsigned char*)(ws + WS_MF + (size_t)blockIdx.x * 393216);
              l1_inv();
              run_gemm_chain(lds, (const bf16_t*)(ws + WS_OC), (const bf16_t*)(wl + WO_UP), 3 * T_TOK, 3 * DM, OCW, TriUnit{u.pm, u.pn, 256},
                             EpiUpChain{Gt, (GAS bf16_t*)(ws + WS_G), 256 * u.pm, 256 * u.pn}); }
        }
        GSYNC();
        {
            PH;
            run_gemm(lds, (const bf16_t*)(ws + WS_G), (const bf16_t*)(wl + WO_OUT), T_TOK, DM, DM, FOut{L == 0 ? (const GAS float*)KA->in[0] : (const GAS float*)nullptr, (const GAS bf16_t*)(ws + WS_XB), (GAS bf16_t*)(ws + WS_PG)});
        }
        GSYNC();
        {
            PH;
            ln_phase((const GAS bf16_t*)(ws + WS_PG), (GAS bf16_t*)(ws + WS_XB), (GAS float*)KA->out, (const GAS float*)KA->in[8] + L * DM, (const GAS float*)KA->in[9] + L * DM, true);
            {
                const GAS f32x4* ps = (const GAS f32x4*)KA->in[1] + (size_t)L * T_TOK * 64; GAS bf16_t* hf = (GAS bf16_t*)(ws + WS_HFF);
                const size_t NT = (size_t)gridDim.x * 512, np = (size_t)T_TOK * 32; size_t i = (size_t)blockIdx.x * 512 + opaque_tid();
                for (; i + 3 * NT < np; i += 4 * NT) {
                    f32x4 v[8];
#pragma unroll
                    for (int k = 0; k < 4; ++k) { v[2 * k] = ps[2 * (i + k * NT)]; v[2 * k + 1] = ps[2 * (i + k * NT) + 1]; }
#pragma unroll
                    for (int k = 0; k < 4; ++k) { const size_t ii = i + k * NT; *(GAS u32x4*)(hf + (ii >> 5) * HFP + (ii & 31) * 8) = pack8(v[2 * k], v[2 * k + 1]); }
                }
                for (; i < np; i += NT) *(GAS u32x4*)(hf + (i >> 5) * HFP + (i & 31) * 8) = pack8(ps[2 * i], ps[2 * i + 1]);
            }
        }
        GSYNC();
        {
            PH;
            run_gemm(lds, (const bf16_t*)(ws + WS_XB), (const bf16_t*)(wl + WO_FF1), T_TOK, NFF1, DM, FFf1{(GAS bf16_t*)(ws + WS_HFF), (GAS bf16_t*)(ws + WS_PG)});
        }
        GSYNC();
        {
            PH;
            run_gemm_ff2(lds, (const bf16_t*)(ws + WS_HFF), (const bf16_t*)(wl + WO_FF2), T_TOK, DM, HFP, EpiFf2{(const GAS bf16_t*)(ws + WS_XB), (GAS bf16_t*)(ws + WS_PG)});
        }
        GSYNC();
        {
            PH;
            ln_phase((const GAS bf16_t*)(ws + WS_PG), (GAS bf16_t*)(ws + WS_XB), (GAS float*)KA->out, (const GAS float*)KA->in[14] + L * DM, (const GAS float*)KA->in[15] + L * DM, L == 0);
        }
        if (Lc == 0) GSYNC();
    }
#undef PH
}

extern "C" void kernel_launch(void* const* d_in, const int* in_sizes, int n_in, void* d_out, int out_size, void* d_ws, size_t ws_size, hipStream_t stream) {
    static int grid_blocks = 0;
    if (grid_blocks == 0) {
        if (n_in != 16 || out_size != T_TOK * DM || ws_size < WS_END) { fprintf(stderr, "kernel_launch: unexpected problem (n_in %d out %d ws %zu, need %zu)\n", n_in, out_size, ws_size, (size_t)WS_END); grid_blocks = -1; return; }
        int dev = 0, cus = 0, per_cu = 0;
        hipGetDevice(&dev);
        hipDeviceGetAttribute(&cus, hipDeviceAttributeMultiprocessorCount, dev);
        hipFuncSetAttribute((const void*)mega_fwd, hipFuncAttributeMaxDynamicSharedMemorySize, LDS_BYTES);
        hipOccupancyMaxActiveBlocksPerMultiprocessor(&per_cu, (const void*)mega_fwd, 512, LDS_BYTES);
        if (per_cu < 1) { fprintf(stderr, "kernel_launch: occupancy query returned %d\n", per_cu); per_cu = 1; }
        grid_blocks = cus * per_cu;
        (void)hipGetLastError();
    }
    if (grid_blocks < 0) return;
    hipMemsetAsync((char*)d_ws + WS_CTL, 0, 32768, stream);
    Args a{};
    for (int i = 0; i < 16; ++i) a.in[i] = (const float*)d_in[i];
    a.out = (float*)d_out; a.ws = (unsigned char*)d_ws;
    void* args[] = {&a};
    hipError_t e = hipLaunchCooperativeKernel((const void*)mega_fwd, dim3(grid_blocks), dim3(512), args, LDS_BYTES, stream);
    if (e != hipSuccess) fprintf(stderr, "cooperative launch failed: %s (grid %d)\n", hipGetErrorString(e), grid_blocks);
}
```

```cpp
#include <hip/hip_runtime.h>
#include <hip/hip_cooperative_groups.h>
#include <cstdio>
#include <cstdint>
namespace cg = cooperative_groups;
__device__ __forceinline__ int opaque_tid() { int t = (int)threadIdx.x; asm volatile("" : "+v"(t)); return t; }
namespace pg8 {
#define PG8_LAS __attribute__((address_space(3)))
typedef unsigned short bf16_t;
typedef short bf16x8 __attribute__((ext_vector_type(8)));
typedef float f32x4 __attribute__((ext_vector_type(4)));
typedef unsigned u32x4 __attribute__((ext_vector_type(4)));
constexpr int BM = 256, BK = 64, HALF = 128, HTB = HALF * BK * 2, STAGE_BYTES = 8 * HTB, NXCD = 8, WGM = 4;

__host__ __device__ __forceinline__ int lds_byte(int r, int c) { const int st = (r >> 4) * 2 + (c >> 5), rr = r & 15, cc = c & 31, ob = rr * 64 + cc * 2; return st * 1024 + (ob ^ (((ob >> 9) & 1) << 5)); }
__host__ __device__ __forceinline__ void stage_rc(int b, int& R, int& C) { const int st = b / 1024, sb = b % 1024, swz = sb ^ (((sb >> 9) & 1) << 5); R = (st >> 1) * 16 + swz / 64; C = (st & 1) * 32 + (swz % 64) / 2; }
__host__ __device__ __forceinline__ int perm32(int rho) { const int n = rho >> 4, i = rho & 15; return 8 * (i >> 2) + 4 * n + (i & 3); }

struct Unit { int pm, pn; };
struct Gemm { const bf16_t* A; const bf16_t* Bt; int M, N, K; };

struct StaticOrder {
    int nM, nN, nwg, G, c;
    __host__ __device__ __forceinline__ void init(int M, int N, int G_, int c_) { nM = M / BM; nN = N / BM; nwg = nM * nN; G = G_; c = c_; }
    __host__ __device__ __forceinline__ bool next(int i, Unit& u) const {
        const long L = (long)i * G + c; if (L >= nwg) return false;
        int wgid = (int)L; { const int q = nwg / NXCD, r = nwg % NXCD, xcd = wgid % NXCD, off = wgid / NXCD; wgid = (xcd < r ? xcd * (q + 1) : r * (q + 1) + (xcd - r) * q) + off; }
        const int nig = WGM * nN, gid = wgid / nig, fm = gid * WGM, gsz = (nM - fm) < WGM ? (nM - fm) : WGM;
        u.pm = fm + ((wgid % nig) % gsz); u.pn = (wgid % nig) / gsz; return true;
    }
    __device__ __forceinline__ void a_ready(const Unit&) const {}
    __device__ __forceinline__ void done(const Unit&) const {}
};

template <class Epi, class Sched, bool ALIGN_EPI = false, bool SP2 = false>
__device__ __forceinline__ void gemm_phase(PG8_LAS unsigned char* lds, const Gemm g, const Sched& S, const Epi& E) {
    const int tid = opaque_tid(), wid = __builtin_amdgcn_readfirstlane(tid >> 6), lane = tid & 63, wr = wid >> 2, wc = wid & 3, fr = lane & 15, fq = lane >> 4;
    const int K = g.K, nt = K / BK;
    unsigned voffA[2], voffB[2];
#pragma unroll
    for (int i = 0; i < 2; ++i) { int R, C; stage_rc(tid * 16 + i * 8192, R, C); const int Rb = Epi::PERM ? ((R & ~31) + perm32(R & 31)) : R;
        voffA[i] = (unsigned)(R * K + C) * 2u; voffB[i] = (unsigned)(Rb * K + C) * 2u; }
    const size_t kstep = (size_t)(BK * 2);
    const size_t hstep = (size_t)HALF * K * 2;
    const size_t tstep = 2 * hstep;
    const unsigned ldsw = (unsigned)wid * 1024u;
    const int aoff = lds_byte(wr * 64 + fr, fq * 8), boff = lds_byte(wc * 32 + fr, fq * 8);
#define PG8_SA(b, h) (((b) * 2 + (h)) * HTB)
#define PG8_SB(b, h) ((4 + (b) * 2 + (h)) * HTB)
#define PG8_STAGE(bufoff, gbase, voff) do { _Pragma("unroll") for (int _i = 0; _i < 2; ++_i) \
        __builtin_amdgcn_global_load_lds((const unsigned*)((const char*)(gbase) + (voff)[_i]), (PG8_LAS unsigned*)(lds + (bufoff) + ldsw + _i * 8192), 16, 0, 0); } while (0)
#define PG8_LDA(dst, b, h) do { _Pragma("unroll") for (int m = 0; m < 4; ++m) _Pragma("unroll") for (int k = 0; k < 2; ++k) dst[m][k] = *(const PG8_LAS bf16x8*)(lds + PG8_SA(b, h) + aoff + m * 2048 + k * 1024); } while (0)
#define PG8_LDB(dst, b, h) do { _Pragma("unroll") for (int n = 0; n < 2; ++n) _Pragma("unroll") for (int k = 0; k < 2; ++k) dst[n][k] = *(const PG8_LAS bf16x8*)(lds + PG8_SB(b, h) + boff + n * 2048 + k * 1024); } while (0)
#define PG8_MMA(ai, bj, At, Bt) do { __builtin_amdgcn_s_setprio(1); _Pragma("unroll") for (int m = 0; m < 4; ++m) _Pragma("unroll") for (int n = 0; n < 2; ++n) _Pragma("unroll") for (int k = 0; k < 2; ++k) \
        acc[ai][bj][m][n] = __builtin_amdgcn_mfma_f32_16x16x32_bf16(Bt[n][k], At[m][k], acc[ai][bj][m][n], 0, 0, 0); __builtin_amdgcn_s_setprio(0); } while (0)
#define PG8_WAIT_V(n) asm volatile("s_waitcnt vmcnt(" #n ")" ::: "memory")
#define PG8_WAIT_L(n) asm volatile("s_waitcnt lgkmcnt(" #n ")" ::: "memory")
#define PG8_BAR __builtin_amdgcn_s_barrier()
#define PG8_SCHED __builtin_amdgcn_sched_barrier(0)
    Unit cur, nxt; int ui = 0;
    if (!S.next(0, cur)) return;
    f32x4 acc[2][2][4][2];
#pragma unroll
    for (int a = 0; a < 2; ++a)
#pragma unroll
        for (int b = 0; b < 2; ++b)
#pragma unroll
            for (int m = 0; m < 4; ++m)
#pragma unroll
                for (int n = 0; n < 2; ++n) acc[a][b][m][n] = (f32x4){0.f, 0.f, 0.f, 0.f};
    bf16x8 At[4][2], B0[2][2], B1[2][2];
    const char* cA = (const char*)g.A + (size_t)cur.pm * tstep; const char* cB = (const char*)g.Bt + (size_t)cur.pn * tstep;
    S.a_ready(cur);
    if constexpr (SP2) {
        PG8_STAGE(PG8_SB(0, 0), cB, voffB); PG8_STAGE(PG8_SB(0, 1), cB + hstep, voffB); PG8_STAGE(PG8_SA(0, 0), cA, voffA); PG8_STAGE(PG8_SA(0, 1), cA + hstep, voffA);
        if (wr == 1) PG8_BAR;
        PG8_WAIT_V(2); PG8_BAR;
        PG8_STAGE(PG8_SB(1, 0), cB + kstep, voffB); PG8_STAGE(PG8_SA(1, 0), cA + kstep, voffA); PG8_STAGE(PG8_SB(1, 1), cB + hstep + kstep, voffB);
        PG8_WAIT_V(6); PG8_BAR;
    } else {
        PG8_STAGE(PG8_SB(0, 0), cB, voffB); PG8_STAGE(PG8_SA(0, 0), cA, voffA); PG8_STAGE(PG8_SB(0, 1), cB + hstep, voffB); PG8_STAGE(PG8_SA(0, 1), cA + hstep, voffA);
        if (wr == 1) PG8_BAR;
        PG8_WAIT_V(4); PG8_BAR;
        PG8_STAGE(PG8_SB(1, 0), cB + kstep, voffB); PG8_STAGE(PG8_SA(1, 0), cA + kstep, voffA); PG8_STAGE(PG8_SB(1, 1), cB + hstep + kstep, voffB);
        PG8_WAIT_V(6); PG8_BAR;
    }
    for (;;) {
        const bool has_next = S.next(ui + 1, nxt);
        const char* nA = has_next ? (const char*)g.A + (size_t)nxt.pm * tstep : cA; const char* nB = has_next ? (const char*)g.Bt + (size_t)nxt.pn * tstep : cB;
        constexpr int NSEG = Epi::MIDK > 0 ? 2 : 1;
#pragma unroll
        for (int seg = 0; seg < NSEG; ++seg) {
        const int t0 = (NSEG == 2 && seg == 1) ? Epi::MIDK : 0, t1 = (NSEG == 2 && seg == 0) ? Epi::MIDK : nt;
        if constexpr (Epi::MIDK > 0) { if (seg == 1) E.mid(acc, cur, wr, wc, fr, fq); }
#pragma unroll 1
        for (int t = t0; t < t1; t += 2) {
            const bool last = (t == nt - 2);
            const char* a1 = cA + (size_t)(t + 1) * kstep;
            const char* a2 = last ? nA : cA + (size_t)(t + 2) * kstep; const char* b2 = last ? nB : cB + (size_t)(t + 2) * kstep;
            const char* a3 = a2 + kstep; const char* b3 = b2 + kstep;
            if (last && has_next) S.a_ready(nxt);
            if constexpr (SP2) {
            PG8_LDB(B0, 0, 0); PG8_LDB(B1, 0, 1); PG8_SCHED; PG8_LDA(At, 0, 0); PG8_STAGE(PG8_SA(1, 1), a1 + hstep, voffA);
            PG8_WAIT_V(8); PG8_WAIT_L(0); PG8_BAR; PG8_MMA(0, 0, At, B0); PG8_MMA(0, 1, At, B1); PG8_BAR; PG8_SCHED;
            PG8_LDA(At, 0, 1); PG8_STAGE(PG8_SB(0, 0), b2, voffB); PG8_STAGE(PG8_SB(0, 1), b2 + hstep, voffB); PG8_STAGE(PG8_SA(0, 0), a2, voffA);
            PG8_WAIT_V(8); PG8_WAIT_L(0); PG8_BAR; PG8_MMA(1, 0, At, B0); PG8_MMA(1, 1, At, B1); PG8_BAR; PG8_SCHED;
            PG8_LDB(B0, 1, 0); PG8_LDB(B1, 1, 1); PG8_SCHED; PG8_LDA(At, 1, 0); PG8_STAGE(PG8_SA(0, 1), a2 + hstep, voffA);
            PG8_WAIT_V(8); PG8_WAIT_L(0); PG8_BAR; PG8_MMA(0, 0, At, B0); PG8_MMA(0, 1, At, B1); PG8_BAR; PG8_SCHED;
            PG8_LDA(At, 1, 1); PG8_STAGE(PG8_SB(1, 0), b3, voffB); PG8_STAGE(PG8_SB(1, 1), b3 + hstep, voffB); PG8_STAGE(PG8_SA(1, 0), a3, voffA);
            PG8_WAIT_V(8); PG8_WAIT_L(0); PG8_BAR; PG8_MMA(1, 0, At, B0); PG8_MMA(1, 1, At, B1); PG8_BAR; PG8_SCHED;
            } else {
            PG8_LDB(B0, 0, 0); PG8_SCHED; PG8_LDA(At, 0, 0); PG8_STAGE(PG8_SA(1, 1), a1 + hstep, voffA);
            PG8_WAIT_L(8); PG8_BAR; PG8_WAIT_L(0); PG8_MMA(0, 0, At, B0); PG8_BAR; PG8_SCHED;
            PG8_LDB(B1, 0, 1); PG8_STAGE(PG8_SB(0, 0), b2, voffB);
            PG8_BAR; PG8_WAIT_L(0); PG8_MMA(0, 1, At, B1); PG8_BAR;
            PG8_LDA(At, 0, 1); PG8_STAGE(PG8_SA(0, 0), a2, voffA);
            PG8_BAR; PG8_WAIT_L(0); PG8_MMA(1, 0, At, B0); PG8_BAR; PG8_SCHED;
            PG8_STAGE(PG8_SB(0, 1), b2 + hstep, voffB);
            PG8_WAIT_V(6); PG8_BAR; PG8_MMA(1, 1, At, B1); PG8_BAR;
            PG8_LDB(B0, 1, 0); PG8_SCHED; PG8_LDA(At, 1, 0); PG8_STAGE(PG8_SA(0, 1), a2 + hstep, voffA);
            PG8_WAIT_L(8); PG8_BAR; PG8_WAIT_L(0); PG8_MMA(0, 0, At, B0); PG8_BAR; PG8_SCHED;
            PG8_LDB(B1, 1, 1); PG8_STAGE(PG8_SB(1, 0), b3, voffB);
            PG8_BAR; PG8_WAIT_L(0); PG8_MMA(0, 1, At, B1); PG8_BAR;
            PG8_LDA(At, 1, 1); PG8_STAGE(PG8_SA(1, 0), a3, voffA);
            PG8_BAR; PG8_WAIT_L(0); PG8_MMA(1, 0, At, B0); PG8_BAR; PG8_SCHED;
            PG8_STAGE(PG8_SB(1, 1), b3 + hstep, voffB);
            PG8_WAIT_V(6); PG8_BAR; PG8_MMA(1, 1, At, B1); PG8_BAR;
            }
        }
        }
        if constexpr (ALIGN_EPI) { if (wr == 0) PG8_BAR; }
        if constexpr (Epi::CHAIN) {
            E.chain(acc, cur, has_next, wr, wc, fr, fq); S.done(cur);
            if (!has_next) break;
        } else {
        if constexpr (!Epi::AFTER_DRAIN) { E(acc, cur, wr, wc, fr, fq); S.done(cur); }
        if (!has_next) break;
#pragma unroll
        for (int a = 0; a < 2; ++a)
#pragma unroll
            for (int b = 0; b < 2; ++b)
#pragma unroll
                for (int m = 0; m < 4; ++m)
#pragma unroll
                    for (int n = 0; n < 2; ++n) acc[a][b][m][n] = (f32x4){0.f, 0.f, 0.f, 0.f};
        }
        cur = nxt; cA = nA; cB = nB; ++ui;
        if constexpr (ALIGN_EPI) { if (wr == 1) PG8_BAR; }
    }
    PG8_WAIT_V(0);
    if constexpr (!ALIGN_EPI) { if (wr == 0) PG8_BAR; }
    PG8_BAR;
    if constexpr (Epi::AFTER_DRAIN) { E.fused(acc, cur, wr, wc, fr, fq, lds, wid, lane); S.done(cur); }
#undef PG8_SA
#undef PG8_SB
#undef PG8_STAGE
#undef PG8_LDA
#undef PG8_LDB
#undef PG8_MMA
#undef PG8_WAIT_V
#undef PG8_WAIT_L
#undef PG8_BAR
#undef PG8_SCHED
}
}
using pg8::bf16_t; using pg8::bf16x8; using pg8::f32x4; using pg8::u32x4;
#define LAS __attribute__((address_space(3)))
#define GAS __attribute__((address_space(1)))
typedef float f32x16 __attribute__((ext_vector_type(16)));
typedef short s16x4 __attribute__((ext_vector_type(4)));
typedef float f32x2_t __attribute__((ext_vector_type(2)));
typedef __bf16 bf16x2_t __attribute__((ext_vector_type(2)));
typedef unsigned u32x2 __attribute__((ext_vector_type(2)));
typedef short v4i16_t __attribute__((ext_vector_type(4)));
#define MFMA32(a, b, c) __builtin_amdgcn_mfma_f32_32x32x16_bf16((a), (b), (c), 0, 0, 0)

constexpr int T_TOK = 65536, SEQ = 2048, DM = 1024, LDH = 3136, NIN = 3328, CIN = 6222, DFF = 4096, NFF1 = 5120, OCW = 384, HFP = 256 + DFF;
constexpr float ALPHA = 1.4142135623730951f, L2E = 1.4426950408889634f, LN_EPS = 1e-5f, NEGF = -1e30f;
constexpr size_t MiB = (size_t)1 << 20;
constexpr size_t WS_CTL = 0, WS_TRIG = 1 * MiB, WS_W = 2 * MiB, W_LAYER = 40 * MiB;
constexpr size_t WO_IN = 0, WO_G = 7 * MiB, WO_UP = 13 * MiB, WO_OUT = 16 * MiB, WO_FF1 = 18 * MiB, WO_FF2 = 28 * MiB, WO_PLE = 36 * MiB;
constexpr size_t WS_PB = 82 * MiB, WS_MB = 146 * MiB, WS_FL = 162 * MiB, WS_IW = 164 * MiB, WS_XB = 166 * MiB, WS_OC = 294 * MiB, WS_A = 438 * MiB;
constexpr size_t WS_HA = WS_A, WS_SCR = WS_A + 392 * MiB, WS_HFF = WS_A, WS_MF = WS_A, WS_G = WS_A + 256 * MiB, WS_PG = WS_OC, WS_END = 984 * MiB;
constexpr size_t OC_STRIDE = (size_t)T_TOK * OCW;
constexpr int LDS_SLOT = 131072, LDS_BYTES = 131072 + 256;

__device__ __forceinline__ unsigned cvtpk(float lo, float hi) { f32x2_t v = {lo, hi}; bf16x2_t b = __builtin_convertvector(v, bf16x2_t); return __builtin_bit_cast(unsigned, b); }
__device__ __forceinline__ float bflo(unsigned w) { return __uint_as_float(w << 16); }
__device__ __forceinline__ float bfhi(unsigned w) { return __uint_as_float(w & 0xffff0000u); }
__device__ __forceinline__ u32x4 pack8(f32x4 a, f32x4 b) { u32x4 w; w.x = cvtpk(a[0], a[1]); w.y = cvtpk(a[2], a[3]); w.z = cvtpk(b[0], b[1]); w.w = cvtpk(b[2], b[3]); return w; }
__device__ __forceinline__ float ex2(float x) { return __builtin_amdgcn_exp2f(x); }
__device__ __forceinline__ float sigm(float x) { return __builtin_amdgcn_rcpf(1.f + ex2(-x * L2E)); }
__device__ __forceinline__ void l1_inv() { __builtin_amdgcn_fence(__ATOMIC_ACQUIRE, "agent"); }

struct NoLoad {};
template <class F> struct EpiF {
    static constexpr bool PERM = true, AFTER_DRAIN = false, CHAIN = false; static constexpr int MIDK = 0; F f;
    __device__ __forceinline__ void operator()(const f32x4 (&acc)[2][2][4][2], const pg8::Unit& u, int wr, int wc, int fr, int fq) const {
        const int row0 = u.pm * 256 + wr * 64 + fr, col0 = u.pn * 256 + wc * 32 + 8 * fq;
        f.begin();
        typename F::L cur0 = f.load(row0, col0), cur1 = f.load(row0, col0 + 128);
#pragma unroll
        for (int b = 0; b < 8; ++b) {
            const int row = row0 + (b >> 2) * 128 + (b & 3) * 16;
            typename F::L nxt0 = cur0, nxt1 = cur1;
            if (b + 1 < 8) { const int rn = row0 + ((b + 1) >> 2) * 128 + ((b + 1) & 3) * 16; nxt0 = f.load(rn, col0); nxt1 = f.load(rn, col0 + 128); }
            f.apply(row, col0, acc[b >> 2][0][b & 3][0], acc[b >> 2][0][b & 3][1], cur0);
            f.apply(row, col0 + 128, acc[b >> 2][1][b & 3][0], acc[b >> 2][1][b & 3][1], cur1);
            cur0 = nxt0; cur1 = nxt1;
        }
    }
};
struct FIn {
    struct L { f32x4 t0, t1; };
    GAS bf16_t* HA; GAS float* FL; GAS float* IW; const GAS float* cs;
    __device__ __forceinline__ void begin() const {}
    static __device__ __forceinline__ bool is_rope(int c0) { return (c0 >= 2112 && c0 < 2496) || (c0 >= 2560 && c0 < 3136); }
    __device__ __forceinline__ L load(int row, int c0) const {
        L l; l.t0 = (f32x4){1.f, 0.f, 1.f, 0.f}; l.t1 = l.t0;
        if (is_rope(c0)) { const int pos = row & (SEQ - 1), i0 = (c0 & 63) >> 1; const GAS float* tp = cs + ((size_t)pos * 32 + i0) * 2; l.t0 = *(const GAS f32x4*)tp; l.t1 = *(const GAS f32x4*)(tp + 4); }
        return l;
    }
    __device__ __forceinline__ void apply(int row, int c0, f32x4 v0, f32x4 v1, const L& l) const {
        if (c0 >= 3152) return;
        if (c0 >= 3136) { GAS float* d = (c0 == 3136 ? FL : IW) + (size_t)row * 8; *(GAS f32x4*)d = v0; *(GAS f32x4*)(d + 4) = v1; return; }
        if (is_rope(c0)) {
            const f32x4 t0 = l.t0, t1 = l.t1;
            float a, b;
            a = v0[0] * t0[0] - v0[1] * t0[1]; b = v0[1] * t0[0] + v0[0] * t0[1]; v0[0] = a; v0[1] = b;
            a = v0[2] * t0[2] - v0[3] * t0[3]; b = v0[3] * t0[2] + v0[2] * t0[3]; v0[2] = a; v0[3] = b;
            a = v1[0] * t1[0] - v1[1] * t1[1]; b = v1[1] * t1[0] + v1[0] * t1[1]; v1[0] = a; v1[1] = b;
            a = v1[2] * t1[2] - v1[3] * t1[3]; b = v1[3] * t1[2] + v1[2] * t1[3]; v1[2] = a; v1[3] = b;
        }
        const bool isq = (c0 < 384) || (c0 >= 1152 && c0 < 1472) || (c0 >= 2112 && c0 < 2432);
        if (isq) { v0 = v0 * (0.125f * L2E); v1 = v1 * (0.125f * L2E); }
        *(GAS u32x4*)(HA + (size_t)row * LDH + c0) = pack8(v0, v1);
    }
};
struct FGateT {
    typedef NoLoad L;
    GAS unsigned char* Gt; int ro, co;
    __device__ __forceinline__ void begin() const {}
    __device__ __forceinline__ L load(int, int) const { return L{}; }
    __device__ __forceinline__ void apply(int row, int c0, f32x4 v0, f32x4 v1, const L&) const {
        u32x2 w; w.x = 0u; w.y = 0u;
        w.x = __builtin_amdgcn_cvt_pk_u8_f32(sigm(v0[0]) * 255.f, 0, w.x); w.x = __builtin_amdgcn_cvt_pk_u8_f32(sigm(v0[1]) * 255.f, 1, w.x);
        w.x = __builtin_amdgcn_cvt_pk_u8_f32(sigm(v0[2]) * 255.f, 2, w.x); w.x = __builtin_amdgcn_cvt_pk_u8_f32(sigm(v0[3]) * 255.f, 3, w.x);
        w.y = __builtin_amdgcn_cvt_pk_u8_f32(sigm(v1[0]) * 255.f, 0, w.y); w.y = __builtin_amdgcn_cvt_pk_u8_f32(sigm(v1[1]) * 255.f, 1, w.y);
        w.y = __builtin_amdgcn_cvt_pk_u8_f32(sigm(v1[2]) * 255.f, 2, w.y); w.y = __builtin_amdgcn_cvt_pk_u8_f32(sigm(v1[3]) * 255.f, 3, w.y);
        *(GAS u32x2*)(Gt + (row - ro) * 256 + (c0 - co)) = w;
    }
};
struct FUpT {
    struct L { u32x2 g; u32x4 m; };
    const GAS unsigned char* Gt; GAS bf16_t* Mt; GAS bf16_t* MG; int ro, co, mode;
    __device__ __forceinline__ void begin() const { l1_inv(); }
    __device__ __forceinline__ L load(int row, int c0) const {
        const int o = (row - ro) * 256 + (c0 - co);
        L l; l.g = *(const GAS u32x2*)(Gt + o); l.m = (u32x4){0u, 0u, 0u, 0u};
        if (mode != 0) l.m = *(const GAS u32x4*)(Mt + o);
        return l;
    }
    __device__ __forceinline__ void apply(int row, int c0, f32x4 v0, f32x4 v1, const L& l) const {
        const int o = (row - ro) * 256 + (c0 - co);
        const float k = 1.f / 255.f; const u32x2 g = l.g; const u32x4 m = l.m;
        f32x4 r0, r1;
        r0[0] = bflo(m.x) + (float)((g.x >> 0) & 0xffu) * k * v0[0]; r0[1] = bfhi(m.x) + (float)((g.x >> 8) & 0xffu) * k * v0[1];
        r0[2] = bflo(m.y) + (float)((g.x >> 16) & 0xffu) * k * v0[2]; r0[3] = bfhi(m.y) + (float)((g.x >> 24) & 0xffu) * k * v0[3];
        r1[0] = bflo(m.z) + (float)((g.y >> 0) & 0xffu) * k * v1[0]; r1[1] = bfhi(m.z) + (float)((g.y >> 8) & 0xffu) * k * v1[1];
        r1[2] = bflo(m.w) + (float)((g.y >> 16) & 0xffu) * k * v1[2]; r1[3] = bfhi(m.w) + (float)((g.y >> 24) & 0xffu) * k * v1[3];
        if (mode != 2) *(GAS u32x4*)(Mt + o) = pack8(r0, r1);
        else *(GAS u32x4*)(MG + (size_t)row * DM + c0) = pack8(r0, r1);
    }
};
struct FGateT3 {
    typedef NoLoad L;
    GAS unsigned char* Gt; int ro, co;
    __device__ __forceinline__ void begin() const {}
    __device__ __forceinline__ L load(int, int) const { return L{}; }
    __device__ __forceinline__ void apply(int row, int c0, f32x4 v0, f32x4 v1, const L&) const {
        const int j = c0 >> 10;
        u32x2 w; w.x = 0u; w.y = 0u;
        w.x = __builtin_amdgcn_cvt_pk_u8_f32(sigm(v0[0]) * 255.f, 0, w.x); w.x = __builtin_amdgcn_cvt_pk_u8_f32(sigm(v0[1]) * 255.f, 1, w.x);
        w.x = __builtin_amdgcn_cvt_pk_u8_f32(sigm(v0[2]) * 255.f, 2, w.x); w.x = __builtin_amdgcn_cvt_pk_u8_f32(sigm(v0[3]) * 255.f, 3, w.x);
        w.y = __builtin_amdgcn_cvt_pk_u8_f32(sigm(v1[0]) * 255.f, 0, w.y); w.y = __builtin_amdgcn_cvt_pk_u8_f32(sigm(v1[1]) * 255.f, 1, w.y);
        w.y = __builtin_amdgcn_cvt_pk_u8_f32(sigm(v1[2]) * 255.f, 2, w.y); w.y = __builtin_amdgcn_cvt_pk_u8_f32(sigm(v1[3]) * 255.f, 3, w.y);
        *(GAS u32x2*)(Gt + j * 65536 + (row - ro) * 256 + ((c0 & 1023) - co)) = w;
    }
};
struct FUpT3 {
    struct L { u32x2 g; u32x4 m; };
    const GAS unsigned char* Gt; GAS bf16_t* Mt; GAS bf16_t* MG; int ro, co;
    __device__ __forceinline__ void begin() const { l1_inv(); }
    __device__ __forceinline__ L load(int row, int c0) const {
        const int j = c0 >> 10; const int o = (row - j * T_TOK - ro) * 256 + ((c0 & 1023) - co);
        L l; l.g = *(const GAS u32x2*)(Gt + j * 65536 + o); l.m = (u32x4){0u, 0u, 0u, 0u};
        if (j != 0) l.m = *(const GAS u32x4*)(Mt + o);
        return l;
    }
    __device__ __forceinline__ void apply(int row, int c0, f32x4 v0, f32x4 v1, const L& l) const {
        const int j = c0 >> 10; const int rr = row - j * T_TOK, cc = c0 & 1023; const int o = (rr - ro) * 256 + (cc - co);
        const float k = 1.f / 255.f; const u32x2 g = l.g; const u32x4 m = l.m;
        f32x4 r0, r1;
        r0[0] = bflo(m.x) + (float)((g.x >> 0) & 0xffu) * k * v0[0]; r0[1] = bfhi(m.x) + (float)((g.x >> 8) & 0xffu) * k * v0[1];
        r0[2] = bflo(m.y) + (float)((g.x >> 16) & 0xffu) * k * v0[2]; r0[3] = bfhi(m.y) + (float)((g.x >> 24) & 0xffu) * k * v0[3];
        r1[0] = bflo(m.z) + (float)((g.y >> 0) & 0xffu) * k * v1[0]; r1[1] = bfhi(m.z) + (float)((g.y >> 8) & 0xffu) * k * v1[1];
        r1[2] = bflo(m.w) + (float)((g.y >> 16) & 0xffu) * k * v1[2]; r1[3] = bfhi(m.w) + (float)((g.y >> 24) & 0xffu) * k * v1[3];
        if (j != 2) *(GAS u32x4*)(Mt + o) = pack8(r0, r1);
        else *(GAS u32x4*)(MG + (size_t)rr * DM + cc) = pack8(r0, r1);
    }
};
struct EpiUpChain {
    static constexpr bool PERM = true, AFTER_DRAIN = false, CHAIN = true; static constexpr int MIDK = 0;
    const GAS unsigned char* Gt; GAS bf16_t* MG; int ro, co;
    __device__ __forceinline__ void operator()(const f32x4 (&)[2][2][4][2], const pg8::Unit&, int, int, int, int) const {}
    static __device__ __forceinline__ float gb(unsigned w, int sh) { return (float)max((w >> sh) & 0xffu, 1u); }
    __device__ __forceinline__ void chain(f32x4 (&acc)[2][2][4][2], const pg8::Unit& u, bool has_next, int wr, int wc, int fr, int fq) const {
        const int j = u.pn >> 2;
        const GAS unsigned char* ga_p = Gt + j * 65536 + (wr * 64 + fr) * 256 + wc * 32 + 8 * fq;
        if (has_next) {
#pragma unroll
            for (int h2 = 0; h2 < 2; ++h2) {
                u32x2 ga[8], gn[8];
#pragma unroll
                for (int m = 0; m < 4; ++m)
#pragma unroll
                    for (int bj = 0; bj < 2; ++bj) { const int o = (h2 * 128 + m * 16) * 256 + bj * 128; ga[2 * m + bj] = *(const GAS u32x2*)(ga_p + o); gn[2 * m + bj] = *(const GAS u32x2*)(ga_p + 65536 + o); }
#pragma unroll
                for (int m = 0; m < 4; ++m)
#pragma unroll
                    for (int bj = 0; bj < 2; ++bj) {
                        const u32x2 a = ga[2 * m + bj], n = gn[2 * m + bj];
                        f32x4 v0 = acc[h2][bj][m][0], v1 = acc[h2][bj][m][1];
                        v0[0] *= gb(a.x, 0) * __builtin_amdgcn_rcpf(gb(n.x, 0)); v0[1] *= gb(a.x, 8) * __builtin_amdgcn_rcpf(gb(n.x, 8));
                        v0[2] *= gb(a.x, 16) * __builtin_amdgcn_rcpf(gb(n.x, 16)); v0[3] *= gb(a.x, 24) * __builtin_amdgcn_rcpf(gb(n.x, 24));
                        v1[0] *= gb(a.y, 0) * __builtin_amdgcn_rcpf(gb(n.y, 0)); v1[1] *= gb(a.y, 8) * __builtin_amdgcn_rcpf(gb(n.y, 8));
                        v1[2] *= gb(a.y, 16) * __builtin_amdgcn_rcpf(gb(n.y, 16)); v1[3] *= gb(a.y, 24) * __builtin_amdgcn_rcpf(gb(n.y, 24));
                        acc[h2][bj][m][0] = v0; acc[h2][bj][m][1] = v1;
                    }
            }
        } else {
#pragma unroll
            for (int h2 = 0; h2 < 2; ++h2) {
                u32x2 ga[8];
#pragma unroll
                for (int m = 0; m < 4; ++m)
#pragma unroll
                    for (int bj = 0; bj < 2; ++bj) ga[2 * m + bj] = *(const GAS u32x2*)(ga_p + (h2 * 128 + m * 16) * 256 + bj * 128);
#pragma unroll
                for (int m = 0; m < 4; ++m)
#pragma unroll
                    for (int bj = 0; bj < 2; ++bj) {
                        const u32x2 a = ga[2 * m + bj]; const float k = 1.f / 255.f;
                        f32x4 v0 = acc[h2][bj][m][0], v1 = acc[h2][bj][m][1];
                        v0[0] *= gb(a.x, 0) * k; v0[1] *= gb(a.x, 8) * k; v0[2] *= gb(a.x, 16) * k; v0[3] *= gb(a.x, 24) * k;
                        v1[0] *= gb(a.y, 0) * k; v1[1] *= gb(a.y, 8) * k; v1[2] *= gb(a.y, 16) * k; v1[3] *= gb(a.y, 24) * k;
                        const int row = ro + wr * 64 + fr + h2 * 128 + m * 16, col = co + wc * 32 + 8 * fq + bj * 128;
                        *(GAS u32x4*)(MG + (size_t)row * DM + col) = pack8(v0, v1);
                    }
            }
        }
    }
};
struct EpiFf2 {
    static constexpr bool PERM = true, AFTER_DRAIN = false, CHAIN = false; static constexpr int MIDK = 4;
    const GAS bf16_t* XB; GAS bf16_t* PG;
    __device__ __forceinline__ void mid(f32x4 (&acc)[2][2][4][2], const pg8::Unit& u, int wr, int wc, int fr, int fq) const {
        const size_t base = (size_t)(u.pm * 256 + wr * 64 + fr) * DM + u.pn * 256 + wc * 32 + 8 * fq;
#pragma unroll
        for (int b = 0; b < 8; b += 4) {
            u32x4 g[8], x[8];
#pragma unroll
            for (int i = 0; i < 8; ++i) { const int bb = b + (i >> 1), bj = i & 1; const size_t o = base + (size_t)((bb >> 2) * 128 + (bb & 3) * 16) * DM + bj * 128; g[i] = *(const GAS u32x4*)(PG + o); x[i] = *(const GAS u32x4*)(XB + o); }
#pragma unroll
            for (int i = 0; i < 8; ++i) {
                const int bb = b + (i >> 1), bj = i & 1; const u32x4 gg = g[i], xx = x[i];
                f32x4 v0 = acc[bb >> 2][bj][bb & 3][0], v1 = acc[bb >> 2][bj][bb & 3][1];
                v0[0] = v0[0] * bflo(gg.x) + ALPHA * bflo(xx.x); v0[1] = v0[1] * bfhi(gg.x) + ALPHA * bfhi(xx.x); v0[2] = v0[2] * bflo(gg.y) + ALPHA * bflo(xx.y); v0[3] = v0[3] * bfhi(gg.y) + ALPHA * bfhi(xx.y);
                v1[0] = v1[0] * bflo(gg.z) + ALPHA * bflo(xx.z); v1[1] = v1[1] * bfhi(gg.z) + ALPHA * bfhi(xx.z); v1[2] = v1[2] * bflo(gg.w) + ALPHA * bflo(xx.w); v1[3] = v1[3] * bfhi(gg.w) + ALPHA * bfhi(xx.w);
                acc[bb >> 2][bj][bb & 3][0] = v0; acc[bb >> 2][bj][bb & 3][1] = v1;
            }
        }
        asm volatile("s_waitcnt vmcnt(0)" ::: "memory");
    }
    __device__ __forceinline__ void operator()(const f32x4 (&acc)[2][2][4][2], const pg8::Unit& u, int wr, int wc, int fr, int fq) const {
        const size_t base = (size_t)(u.pm * 256 + wr * 64 + fr) * DM + u.pn * 256 + wc * 32 + 8 * fq;
#pragma unroll
        for (int b = 0; b < 8; ++b)
#pragma unroll
            for (int bj = 0; bj < 2; ++bj)
                *(GAS u32x4*)(PG + base + (size_t)((b >> 2) * 128 + (b & 3) * 16) * DM + bj * 128) = pack8(acc[b >> 2][bj][b & 3][0], acc[b >> 2][bj][b & 3][1]);
    }
};
struct TriUnit {
    int pm, pn, dpm;
    __device__ __forceinline__ bool next(int i, pg8::Unit& o) const { if (i >= 3) return false; o.pm = pm + i * dpm; o.pn = pn + 4 * i; return true; }
    __device__ __forceinline__ void a_ready(const pg8::Unit&) const {}
    __device__ __forceinline__ void done(const pg8::Unit&) const {}
};
struct OneUnit {
    pg8::Unit u;
    __device__ __forceinline__ bool next(int i, pg8::Unit& o) const { if (i != 0) return false; o = u; return true; }
    __device__ __forceinline__ void a_ready(const pg8::Unit&) const {}
    __device__ __forceinline__ void done(const pg8::Unit&) const {}
};
struct FOut {
    struct L { u32x4 g; f32x4 a, b; };
    const GAS float* res; const GAS bf16_t* resb; GAS bf16_t* dst;
    __device__ __forceinline__ void begin() const {}
    __device__ __forceinline__ L load(int row, int c0) const {
        const size_t o = (size_t)row * DM + c0; L l; l.g = (u32x4){0u, 0u, 0u, 0u}; l.a = (f32x4){0.f, 0.f, 0.f, 0.f}; l.b = l.a;
        if (res) { l.a = *(const GAS f32x4*)(res + o); l.b = *(const GAS f32x4*)(res + o + 4); } else l.g = *(const GAS u32x4*)(resb + o);
        return l;
    }
    __device__ __forceinline__ void apply(int row, int c0, f32x4 v0, f32x4 v1, const L& l) const {
        const size_t o = (size_t)row * DM + c0;
        f32x4 a = l.a, b = l.b;
        if (!res) { const u32x4 g = l.g; a = (f32x4){bflo(g.x), bfhi(g.x), bflo(g.y), bfhi(g.y)}; b = (f32x4){bflo(g.z), bfhi(g.z), bflo(g.w), bfhi(g.w)}; }
        *(GAS u32x4*)(dst + o) = pack8(a * ALPHA + v0, b * ALPHA + v1);
    }
};
struct FFf1 {
    typedef NoLoad L;
    GAS bf16_t* HF; GAS bf16_t* PG;
    __device__ __forceinline__ void begin() const {}
    __device__ __forceinline__ L load(int, int) const { return L{}; }
    __device__ __forceinline__ void apply(int row, int c0, f32x4 v0, f32x4 v1, const L&) const {
        if (c0 < DFF) {
#pragma unroll
            for (int i = 0; i < 4; ++i) { const float a = fmaxf(v0[i], 0.f), b = fmaxf(v1[i], 0.f); v0[i] = a * a; v1[i] = b * b; }
            *(GAS u32x4*)(HF + (size_t)row * HFP + 256 + c0) = pack8(v0, v1);
        } else {
#pragma unroll
            for (int i = 0; i < 4; ++i) { v0[i] = sigm(v0[i]); v1[i] = sigm(v1[i]); }
            *(GAS u32x4*)(PG + (size_t)row * DM + (c0 - DFF)) = pack8(v0, v1);
        }
    }
};
struct FPle {
    struct L { u32x4 g; };
    GAS bf16_t* PG;
    __device__ __forceinline__ void begin() const {}
    __device__ __forceinline__ L load(int row, int c0) const { L l; l.g = *(const GAS u32x4*)(PG + (size_t)row * DM + c0); return l; }
    __device__ __forceinline__ void apply(int row, int c0, f32x4 v0, f32x4 v1, const L& l) const {
        const size_t o = (size_t)row * DM + c0; const u32x4 g = l.g;
        v0[0] *= bflo(g.x); v0[1] *= bfhi(g.x); v0[2] *= bflo(g.y); v0[3] *= bfhi(g.y);
        v1[0] *= bflo(g.z); v1[1] *= bfhi(g.z); v1[2] *= bflo(g.w); v1[3] *= bfhi(g.w);
        *(GAS u32x4*)(PG + o) = pack8(v0, v1);
    }
};
struct FFf2 {
    struct L { u32x4 g, x; };
    const GAS bf16_t* XB; GAS bf16_t* PG;
    __device__ __forceinline__ void begin() const { l1_inv(); }
    __device__ __forceinline__ L load(int row, int c0) const { const size_t o = (size_t)row * DM + c0; L l; l.g = *(const GAS u32x4*)(PG + o); l.x = *(const GAS u32x4*)(XB + o); return l; }
    __device__ __forceinline__ void apply(int row, int c0, f32x4 v0, f32x4 v1, const L& l) const {
        const size_t o = (size_t)row * DM + c0;
        const u32x4 g = l.g, x = l.x;
        f32x4 r0 = v0, r1 = v1;
        r0[0] += bflo(g.x) + ALPHA * bflo(x.x); r0[1] += bfhi(g.x) + ALPHA * bfhi(x.x); r0[2] += bflo(g.y) + ALPHA * bflo(x.y); r0[3] += bfhi(g.y) + ALPHA * bfhi(x.y);
        r1[0] += bflo(g.z) + ALPHA * bflo(x.z); r1[1] += bfhi(g.z) + ALPHA * bfhi(x.z); r1[2] += bflo(g.w) + ALPHA * bflo(x.w); r1[3] += bfhi(g.w) + ALPHA * bfhi(x.w);
        *(GAS u32x4*)(PG + o) = pack8(r0, r1);
    }
};
template <class F> __device__ __forceinline__ void run_gemm(LAS unsigned char* lds, const bf16_t* A, const bf16_t* Bt, int M, int N, int K, const F& f) {
    asm volatile("" : "+s"(K), "+s"(N), "+s"(M));
    pg8::Gemm g{A, Bt, M, N, K}; pg8::StaticOrder S; S.init(M, N, (int)gridDim.x, (int)blockIdx.x);
    EpiF<F> E{f};
    pg8::gemm_phase<EpiF<F>, pg8::StaticOrder, true, true>(lds, g, S, E);
}
template <class F> __device__ __forceinline__ void run_gemm_one(LAS unsigned char* lds, const bf16_t* A, const bf16_t* Bt, int M, int N, int K, pg8::Unit u, const F& f) {
    asm volatile("" : "+s"(K), "+s"(N), "+s"(M));
    pg8::Gemm g{A, Bt, M, N, K}; OneUnit S{u};
    EpiF<F> E{f};
    pg8::gemm_phase<EpiF<F>, OneUnit, true, true>(lds, g, S, E);
}
template <class F> __device__ __forceinline__ void run_gemm_tri(LAS unsigned char* lds, const bf16_t* A, const bf16_t* Bt, int M, int N, int K, TriUnit S, const F& f) {
    asm volatile("" : "+s"(K), "+s"(N), "+s"(M));
    pg8::Gemm g{A, Bt, M, N, K};
    EpiF<F> E{f};
    pg8::gemm_phase<EpiF<F>, TriUnit, true, true>(lds, g, S, E);
}
__device__ __forceinline__ void run_gemm_ff2(LAS unsigned char* lds, const bf16_t* A, const bf16_t* Bt, int M, int N, int K, const EpiFf2& E) {
    asm volatile("" : "+s"(K), "+s"(N), "+s"(M));
    pg8::Gemm g{A, Bt, M, N, K}; pg8::StaticOrder S; S.init(M, N, (int)gridDim.x, (int)blockIdx.x);
    pg8::gemm_phase<EpiFf2, pg8::StaticOrder, true, true>(lds, g, S, E);
}
__device__ __forceinline__ void run_gemm_chain(LAS unsigned char* lds, const bf16_t* A, const bf16_t* Bt, int M, int N, int K, TriUnit S, const EpiUpChain& E) {
    asm volatile("" : "+s"(K), "+s"(N), "+s"(M));
    pg8::Gemm g{A, Bt, M, N, K};
    pg8::gemm_phase<EpiUpChain, TriUnit, true, true>(lds, g, S, E);
}
__device__ __forceinline__ int win_src(int n) {
    if (n < 1152) return n;
    if (n < 2112) { const int e = n - 1152; return 1158 + e; }
    if (n < 2432) { const int e = n - 2112, hh = e >> 6, p = e & 63; return 2118 + hh * 64 + (p >> 1) + 32 * (p & 1); }
    if (n < 2496) { const int p = n - 2432; return 2438 + (p >> 1) + 32 * (p & 1); }
    if (n < 2560) return 2502 + (n - 2496);
    if (n < 3072) { const int e = n - 2560, hh = e >> 6, p = e & 63; return 2566 + hh * 64 + (p >> 1) + 32 * (p & 1); }
    if (n < 3136) { const int p = n - 3072; return 3078 + (p >> 1) + 32 * (p & 1); }
    if (n < 3142) return 1152 + (n - 3136);
    if (n < 3144) return -1;
    if (n < 3152) return 3142 + (n - 3144);
    return -1;
}
struct GWin { const float* W; __device__ __forceinline__ float operator()(int k, int n) const { const int s = win_src(n); return s < 0 ? 0.f : W[(size_t)k * CIN + s]; } };
struct GWg { const float* W; int j; __device__ __forceinline__ float operator()(int k, int n) const { return W[(size_t)k * CIN + 3150 + j * DM + n]; } };
struct GUp { const float* W; int kj; __device__ __forceinline__ float operator()(int k, int n) const { return k < kj ? W[(size_t)k * DM + n] : 0.f; } };
struct GPlain { const float* W; int pitch; __device__ __forceinline__ float operator()(int k, int n) const { return W[(size_t)k * pitch + n]; } };
struct GCat { const float* Wp; const float* Wf; __device__ __forceinline__ float operator()(int k, int n) const { return k < 256 ? Wp[(size_t)k * DM + n] : Wf[(size_t)(k - 256) * DM + n]; } };
struct GFf1 { const float* Wf; const float* Wp; __device__ __forceinline__ float operator()(int k, int n) const { return n < DFF ? Wf[(size_t)k * DFF + n] : Wp[(size_t)k * DM + (n - DFF)]; } };
template <class G> __device__ __forceinline__ void tr_item(const G& get, int K, int N, bf16_t* WT, LAS float* scr, int item, int lane) {
    const int nblk = N / 32, kb = item / nblk, nb = item % nblk, k0 = 64 * kb, n0 = 32 * nb;
#pragma unroll 8
    for (int i = 0; i < 32; ++i) { const int kk = 2 * i + (lane >> 5); scr[kk * 33 + (lane & 31)] = get(k0 + kk, n0 + (lane & 31)); }
    asm volatile("s_waitcnt lgkmcnt(0)" ::: "memory");
    const int c = lane & 7;
#pragma unroll
    for (int j = 0; j < 4; ++j) { const int n = (lane >> 3) + 8 * j; const LAS float* s = scr + (8 * c) * 33 + n;
        u32x4 o; o.x = cvtpk(s[0 * 33], s[1 * 33]); o.y = cvtpk(s[2 * 33], s[3 * 33]); o.z = cvtpk(s[4 * 33], s[5 * 33]); o.w = cvtpk(s[6 * 33], s[7 * 33]);
        *(u32x4*)(WT + (size_t)(n0 + n) * K + k0 + 8 * c) = o; }
    asm volatile("s_waitcnt lgkmcnt(0)" ::: "memory");
}
__device__ __forceinline__ void sincos_d(double x, double& s, double& c) {
    const double k = rint(x * 0.63661977236758134308);
    const double r = fma(-k, 6.123233995736766e-17, fma(-k, 1.5707963267948966, x));
    const double r2 = r * r;
    const double sp = r * (1.0 + r2 * (-1.0 / 6 + r2 * (1.0 / 120 + r2 * (-1.0 / 5040 + r2 * (1.0 / 362880 + r2 * (-1.0 / 39916800 + r2 * (1.0 / 6227020800.0)))))));
    const double cp = 1.0 + r2 * (-0.5 + r2 * (1.0 / 24 + r2 * (-1.0 / 720 + r2 * (1.0 / 40320 + r2 * (-1.0 / 3628800 + r2 * (1.0 / 479001600 + r2 * (-1.0 / 87178291200.0)))))));
    const int q = ((int)k) & 3;
    s = (q == 0) ? sp : (q == 1) ? cp : (q == 2) ? -sp : -cp;
    c = (q == 0) ? cp : (q == 1) ? -sp : (q == 2) ? -cp : sp;
}
struct Args { const float* in[16]; float* out; unsigned char* ws; };

__device__ __forceinline__ void prologue(LAS unsigned char* lds, const Args& a) {
    const int tid = opaque_tid(), lane = tid & 63, wid = __builtin_amdgcn_readfirstlane(tid >> 6);
    LAS float* scr = (LAS float*)(lds + wid * 16384);
    const int gw = blockIdx.x * 8 + wid, NGW = gridDim.x * 8;
    unsigned char* ws = a.ws;
    constexpr int I_IN = 16 * (NIN / 32), I_G = 3 * 512, I_UP = 3 * 192, I_OUT = 512, I_FF1 = 16 * (NFF1 / 32), I_FF2 = (HFP / 64) * 32, I_PLE = 0;
    constexpr int I_LAYER = I_IN + I_G + I_UP + I_OUT + I_FF1 + I_FF2 + I_PLE;
    for (int it = gw; it < 2 * I_LAYER; it += NGW) {
        const int L = it / I_LAYER; int r = it % I_LAYER;
        unsigned char* wl = ws + WS_W + (size_t)L * W_LAYER;
        if (r < I_IN) { tr_item(GWin{a.in[2] + (size_t)L * DM * CIN}, DM, NIN, (bf16_t*)(wl + WO_IN), scr, r, lane); continue; } r -= I_IN;
        if (r < I_G) { const int j = r / 512; tr_item(GWg{a.in[2] + (size_t)L * DM * CIN, j}, DM, DM, (bf16_t*)(wl + WO_G) + (size_t)j * DM * DM, scr, r % 512, lane); continue; } r -= I_G;
        if (r < I_UP) { const int j = r / 192; const int kj = j == 0 ? 384 : 320; const float* src = a.in[4 + j] + (size_t)L * kj * DM;
            tr_item(GUp{src, kj}, OCW, DM, (bf16_t*)(wl + WO_UP) + (size_t)j * DM * OCW, scr, r % 192, lane); continue; } r -= I_UP;
        if (r < I_OUT) { tr_item(GPlain{a.in[7] + (size_t)L * DM * DM, DM}, DM, DM, (bf16_t*)(wl + WO_OUT), scr, r, lane); continue; } r -= I_OUT;
        if (r < I_FF1) { tr_item(GFf1{a.in[10] + (size_t)L * DM * DFF, a.in[13] + (size_t)L * DM * DM}, DM, NFF1, (bf16_t*)(wl + WO_FF1), scr, r, lane); continue; } r -= I_FF1;
        tr_item(GCat{a.in[12] + (size_t)L * 256 * DM, a.in[11] + (size_t)L * DFF * DM}, HFP, DM, (bf16_t*)(wl + WO_FF2), scr, r, lane);
    }
    const size_t gt = (size_t)blockIdx.x * 512 + tid, NT = (size_t)gridDim.x * 512;
    {
        const f32x4* x4 = (const f32x4*)a.in[0]; u32x4* xb = (u32x4*)(ws + WS_XB);
        for (size_t i = gt; i < (size_t)T_TOK * DM / 8; i += NT) xb[i] = pack8(x4[2 * i], x4[2 * i + 1]);
    }
    {
        bf16_t* oc = (bf16_t*)(ws + WS_OC);
        for (size_t i = gt; i < (size_t)2 * T_TOK * 8; i += NT) { const size_t j = i / ((size_t)T_TOK * 8), rr = i % ((size_t)T_TOK * 8), row = rr >> 3, ch = rr & 7;
            *(u32x4*)(oc + (1 + j) * OC_STRIDE + row * OCW + 320 + ch * 8) = (u32x4){0u, 0u, 0u, 0u}; }
    }
    {
        float* cs = (float*)(ws + WS_TRIG);
        for (size_t e = gt; e < (size_t)SEQ * 32; e += NT) { const int pos = (int)(e >> 5), i = (int)(e & 31);
            double inv = 1.0; for (int t = 0; t < i; ++t) inv *= 0.7498942093324559;
            const float ang = (float)pos * (float)inv; double s, c; sincos_d((double)ang, s, c);
            cs[2 * e] = (float)c; cs[2 * e + 1] = (float)s; }
    }
}

__device__ __forceinline__ int next_unit(unsigned* ctr, LAS unsigned* slot) {
    __syncthreads();
    if (opaque_tid() == 0) *slot = atomicAdd(ctr, 1u);
    __syncthreads();
    return __builtin_amdgcn_readfirstlane((int)*slot);
}
__device__ __forceinline__ bf16x8 packf8(const f32x16& x, int s) {
    u32x4 w; w.x = cvtpk(x[8 * s], x[8 * s + 1]); w.y = cvtpk(x[8 * s + 2], x[8 * s + 3]); w.z = cvtpk(x[8 * s + 4], x[8 * s + 5]); w.w = cvtpk(x[8 * s + 6], x[8 * s + 7]);
    return __builtin_bit_cast(bf16x8, w);
}
template <int MODE>
__device__ __forceinline__ void attn_unit(LAS unsigned char* lds, const GAS bf16_t* __restrict__ HA, int b, int qb, int qcol, int kcol, int vcol,
                                          GAS bf16_t* __restrict__ O, int ocol, const GAS float* __restrict__ FL, float bfv, const GAS unsigned long long* __restrict__ MB) {
    const int tid = opaque_tid(), lane = tid & 63, r32 = lane & 31, hi = lane >> 5; const int wid = __builtin_amdgcn_readfirstlane(tid >> 6);
    LAS float* cbuf = (LAS float*)(lds + 36864); LAS float* wt = (LAS float*)(lds + 45056); LAS unsigned* flags = (LAS unsigned*)(lds + (MODE == 1 ? 92160 + 64 : 45088));
    const size_t rowbase = (size_t)b * SEQ; const int qw = qb * 256 + wid * 32, q = qw + r32; const int ntiles = 4 * (qb + 1), td = qw >> 6;
    float cq = 0.f;
    if (MODE == 0) {
        float lf[4];
#pragma unroll
        for (int i = 0; i < 4; ++i) { const float x = FL[(rowbase + 4 * tid + i) * 8] + bfv; lf[i] = (fminf(x, 0.f) - __logf(1.f + __expf(-fabsf(x)))) * L2E; }
        const float s1 = lf[0], s2 = s1 + lf[1], s3 = s2 + lf[2], s4 = s3 + lf[3];
        float v = s4;
#pragma unroll
        for (int off = 1; off < 64; off <<= 1) { const float n = __shfl_up(v, off); if (lane >= off) v += n; }
        if (lane == 63) wt[wid] = v;
        __syncthreads();
        float base = 0.f;
#pragma unroll
        for (int w = 0; w < 8; ++w) { const float x = wt[w]; if (w < wid) base += x; }
        const float ex = base + v - s4;
        *(LAS f32x4*)(cbuf + 4 * tid) = (f32x4){ex + s1, ex + s2, ex + s3, ex + s4};
        __syncthreads();
        cq = cbuf[q];
    }
    if (MODE == 1) { if (tid < 8) flags[tid] = 0u; }
    bf16x8 qr[4];
    { const GAS bf16_t* qp = HA + (rowbase + q) * LDH + qcol + hi * 8;
#pragma unroll
      for (int d0 = 0; d0 < 4; ++d0) qr[d0] = *(const GAS bf16x8*)(qp + d0 * 16); }
    bf16x8 T0, T1, ONES;
    if (MODE == 1) {
#pragma unroll
        for (int j = 0; j < 8; ++j) { const int kk = 8 * (j >> 2) + 4 * hi + (j & 3); T0[j] = (kk > r32) ? (short)0x3F80 : (short)0; T1[j] = (16 + kk > r32) ? (short)0x3F80 : (short)0; ONES[j] = (short)0x3F80; }
    }
    LAS unsigned long long* mlds = (LAS unsigned long long*)(lds + 45568) + (wid * 32 + r32) * 33;
    if (MODE == 2) {
        const GAS unsigned long long* mbp = MB + (rowbase + q) * 32 + hi * 16;
        u32x4 mw[8];
#pragma unroll
        for (int i = 0; i < 8; ++i) mw[i] = *(const GAS u32x4*)(mbp + 2 * i);
#pragma unroll
        for (int i = 0; i < 8; ++i) { mlds[hi * 16 + 2 * i] = ((unsigned long long)mw[i].y << 32) | mw[i].x; mlds[hi * 16 + 2 * i + 1] = ((unsigned long long)mw[i].w << 32) | mw[i].z; }
    }
    f32x16 zero16;
#pragma unroll
    for (int i = 0; i < 16; ++i) zero16[i] = 0.f;
    f32x16 o0 = zero16, o1 = zero16;
    float m = 0.f, l = 0.f, R = 0.f; bool uns = true;
    const int skr = tid >> 3, sch = tid & 7;
    const GAS bf16_t* kg = HA + (rowbase + skr) * LDH + kcol + sch * 8;
    const GAS bf16_t* vg = HA + (rowbase + skr) * LDH + vcol + sch * 8;
    const int t_first = (MODE == 1) ? ntiles - 1 : 0;
    u32x4 kreg = *(const GAS u32x4*)(kg + (size_t)t_first * 64 * LDH), vreg = *(const GAS u32x4*)(vg + (size_t)t_first * 64 * LDH);
#define STAGE_TILE(bufi, KR, VR) do { LAS bf16_t* Ks_ = (LAS bf16_t*)(lds + (bufi) * 18432); LAS bf16_t* Vs_ = (LAS bf16_t*)(lds + (bufi) * 18432 + 9216); \
        *(LAS u32x4*)(Ks_ + skr * 72 + sch * 8) = KR; *(LAS u32x4*)(Vs_ + skr * 72 + sch * 8) = VR; } while (0)
#define VTR(p) __builtin_bit_cast(s16x4, __builtin_amdgcn_ds_read_tr16_b64_v4i16((LAS v4i16_t*)(p)))
#define VFRAG(dblk, kb) __builtin_shufflevector(VTR(vp + 16 * (kb) * 72 + 32 * (dblk)), VTR(vp + (16 * (kb) + 8) * 72 + 32 * (dblk)), 0, 1, 2, 3, 4, 5, 6, 7)
#define COMPUTE_TILE(T_, CUR_) do { const int t = (T_); const int cur = (CUR_); \
        if (t <= td) { \
            const LAS bf16_t* Ks = (const LAS bf16_t*)(lds + cur * 18432); const LAS bf16_t* Vt = (const LAS bf16_t*)(lds + cur * 18432 + 9216); \
            unsigned long long bits = 0ull; \
            if (MODE == 2) bits = mlds[t]; \
            const float init = (MODE == 1) ? 0.f : cq - m; \
            const int kbase = t * 64 + 4 * hi; \
            f32x16 p0, p1; \
            if (MODE == 0) { \
_Pragma("unroll") \
                for (int g = 0; g < 4; ++g) { \
                    const f32x4 c0 = *(const LAS f32x4*)(cbuf + kbase + 8 * g), c1 = *(const LAS f32x4*)(cbuf + kbase + 32 + 8 * g); \
_Pragma("unroll") \
                    for (int i = 0; i < 4; ++i) { p0[4 * g + i] = init - c0[i]; p1[4 * g + i] = init - c1[i]; } \
                } \
            } else if (MODE == 2) { \
                const unsigned blo = (unsigned)(bits >> (4 * hi)), bhi = (unsigned)(bits >> (32 + 4 * hi)); \
_Pragma("unroll") \
                for (int r = 0; r < 16; ++r) { const int ix = (r & 3) + 8 * (r >> 2); p0[r] = ((blo >> ix) & 1u) ? init : NEGF; p1[r] = ((bhi >> ix) & 1u) ? init : NEGF; } \
            } else { \
_Pragma("unroll") \
                for (int r = 0; r < 16; ++r) { p0[r] = 0.f; p1[r] = 0.f; } \
            } \
            { const LAS bf16_t* kp = Ks + r32 * 72 + hi * 8; \
_Pragma("unroll") \
              for (int d0 = 0; d0 < 4; ++d0) { \
                  const bf16x8 k0 = *(const LAS bf16x8*)(kp + d0 * 16), k1 = *(const LAS bf16x8*)(kp + 32 * 72 + d0 * 16); \
                  p0 = MFMA32(k0, qr[d0], p0); p1 = MFMA32(k1, qr[d0], p1); \
              } } \
            if (MODE == 1) { \
                f32x16 lb0, lb1; \
_Pragma("unroll") \
                for (int r = 0; r < 16; ++r) { \
                    const int k = kbase + (r & 3) + 8 * (r >> 2); \
                    { const float z = p0[r], sp = fmaxf(z, 0.f) + __builtin_amdgcn_logf(1.f + ex2(-fabsf(z))); float L = -sp, lb = z - sp; if (t == td && k >= q) { L = 0.f; lb = NEGF; } p0[r] = L; lb0[r] = lb; } \
                    { const float z = p1[r], sp = fmaxf(z, 0.f) + __builtin_amdgcn_logf(1.f + ex2(-fabsf(z))); float L = -sp, lb = z - sp; if (t == td && k + 32 >= q) { L = 0.f; lb = NEGF; } p1[r] = L; lb1[r] = lb; } \
                } \
                const bf16x8 L00 = packf8(p0, 0), L01 = packf8(p0, 1), L10 = packf8(p1, 0), L11 = packf8(p1, 1); \
                const f32x16 X1 = MFMA32(ONES, L10, MFMA32(ONES, L11, zero16)); \
                const f32x16 a0 = MFMA32(T0, L00, MFMA32(T1, L01, X1)); \
                const f32x16 a1 = MFMA32(T0, L10, MFMA32(T1, L11, zero16)); \
                const f32x16 tt = MFMA32(ONES, L00, MFMA32(ONES, L01, X1)); \
_Pragma("unroll") \
                for (int r = 0; r < 16; ++r) { p0[r] = ex2(lb0[r] + a0[r] + R); p1[r] = ex2(lb1[r] + a1[r] + R); } \
                R += tt[0]; \
            } else { \
                float mx = NEGF; \
                if (MODE == 0 && t == td) { \
_Pragma("unroll") \
                    for (int r = 0; r < 16; ++r) { const int k = kbase + (r & 3) + 8 * (r >> 2); if (k > q) p0[r] = NEGF; if (k + 32 > q) p1[r] = NEGF; } \
                } \
_Pragma("unroll") \
                for (int r = 0; r < 16; ++r) mx = fmaxf(mx, fmaxf(p0[r], p1[r])); \
                mx = fmaxf(mx, __shfl_xor(mx, 32)); \
 \
                float dl = 0.f, f = 1.f; \
                if (uns) { if (mx > -1e29f) { dl = mx; uns = false; } } \
                else if (mx > 8.f) { dl = mx; f = ex2(-dl); } \
                if (__any(dl != 0.f)) { \
                    m += dl; l *= f; \
_Pragma("unroll") \
                    for (int r = 0; r < 16; ++r) { o0[r] *= f; o1[r] *= f; p0[r] -= dl; p1[r] -= dl; } \
                } \
                float ps = 0.f; \
_Pragma("unroll") \
                for (int r = 0; r < 16; ++r) { p0[r] = ex2(p0[r]); p1[r] = ex2(p1[r]); ps += p0[r] + p1[r]; } \
                l += ps; \
            } \
 \
            const bf16x8 pb0 = packf8(p0, 0), pb1 = packf8(p0, 1), pb2 = packf8(p1, 0), pb3 = packf8(p1, 1); \
 \
            const LAS bf16_t* vp = Vt + (4 * hi + ((lane & 15) >> 2)) * 72 + 16 * ((lane >> 4) & 1) + 4 * (lane & 3); \
            o0 = MFMA32(VFRAG(0, 0), pb0, o0); o0 = MFMA32(VFRAG(0, 1), pb1, o0); o0 = MFMA32(VFRAG(0, 2), pb2, o0); o0 = MFMA32(VFRAG(0, 3), pb3, o0); \
            o1 = MFMA32(VFRAG(1, 0), pb0, o1); o1 = MFMA32(VFRAG(1, 1), pb1, o1); o1 = MFMA32(VFRAG(1, 2), pb2, o1); o1 = MFMA32(VFRAG(1, 3), pb3, o1); \
            if (MODE == 1) { if (__all(R < -160.f) && lane == 0) flags[wid] = 1u; } \
        } \
    } while (0)
#define LOAD_TILE(KR, VR, tl) do { KR = *(const GAS u32x4*)(kg + (size_t)(tl) * 64 * LDH); VR = *(const GAS u32x4*)(vg + (size_t)(tl) * 64 * LDH); } while (0)
#define TILE_OF(it_) ((MODE == 1) ? ntiles - 1 - (it_) : (it_))
    if (MODE == 1) {
        u32x4 k1, v1, k2, v2, k3, v3;
        LOAD_TILE(k1, v1, ntiles - 2); LOAD_TILE(k2, v2, ntiles - 3); LOAD_TILE(k3, v3, ntiles - 4);
        STAGE_TILE((ntiles - 1) % 5, kreg, vreg); STAGE_TILE((ntiles - 2) % 5, k1, v1); STAGE_TILE((ntiles - 3) % 5, k2, v2); STAGE_TILE((ntiles - 4) % 5, k3, v3);
        __syncthreads();
        for (int i = 0; i < ntiles; ++i) {
            const int tnew = ntiles - 5 - i;
            if (tnew >= 0) LOAD_TILE(kreg, vreg, tnew);
            const int tw = td - i;
            if (tw >= 0) COMPUTE_TILE(tw, tw % 5);
            if (tnew >= 0) STAGE_TILE(tnew % 5, kreg, vreg);
            __syncthreads();
            { const u32x4 fa = *(const LAS u32x4*)flags, fb = *(const LAS u32x4*)(flags + 4); if ((fa.x & fa.y & fa.z & fa.w & fb.x & fb.y & fb.z & fb.w) != 0u) break; }
        }
    } else {
    u32x4 kB, vB;
    STAGE_TILE(0, kreg, vreg);
    LOAD_TILE(kB, vB, TILE_OF(1));
    __syncthreads();
    bool stop = false;
    for (int it = 0; it < ntiles && !stop; it += 2) {
        LOAD_TILE(kreg, vreg, TILE_OF(min(it + 2, ntiles - 1)));
        COMPUTE_TILE(TILE_OF(it), 0);
        STAGE_TILE(1, kB, vB);
        __syncthreads();
        if (MODE == 1) { const u32x4 fa = *(const LAS u32x4*)flags, fb = *(const LAS u32x4*)(flags + 4); if ((fa.x & fa.y & fa.z & fa.w & fb.x & fb.y & fb.z & fb.w) != 0u) break; }
        LOAD_TILE(kB, vB, TILE_OF(min(it + 3, ntiles - 1)));
        COMPUTE_TILE(TILE_OF(it + 1), 1);
        STAGE_TILE(0, kreg, vreg);
        __syncthreads();
        if (MODE == 1) { const u32x4 fa = *(const LAS u32x4*)flags, fb = *(const LAS u32x4*)(flags + 4); if ((fa.x & fa.y & fa.z & fa.w & fb.x & fb.y & fb.z & fb.w) != 0u) stop = true; }
    }
    }
#undef LOAD_TILE
#undef TILE_OF
#undef COMPUTE_TILE
#undef VTR
#undef VFRAG
#undef STAGE_TILE
    float inv = 1.f;
    if (MODE != 1) { const float lt = l + __shfl_xor(l, 32); inv = 1.f / lt; }
    GAS bf16_t* op = O + (rowbase + q) * OCW + ocol + 4 * hi;
#pragma unroll
    for (int g = 0; g < 4; ++g) {
        u32x2 w0, w1;
        w0.x = cvtpk(o0[4 * g] * inv, o0[4 * g + 1] * inv); w0.y = cvtpk(o0[4 * g + 2] * inv, o0[4 * g + 3] * inv);
        w1.x = cvtpk(o1[4 * g] * inv, o1[4 * g + 1] * inv); w1.y = cvtpk(o1[4 * g + 2] * inv, o1[4 * g + 3] * inv);
        *(GAS u32x2*)(op + 8 * g) = w0; *(GAS u32x2*)(op + 32 + 8 * g) = w1;
    }
}

__device__ __forceinline__ unsigned skey_of(float f) { const unsigned u = __float_as_uint(f); return u ^ ((unsigned)((int)u >> 31) | 0x80000000u); }
template <int NJ>
__device__ __forceinline__ void select_rows(const GAS float* sr0, GAS unsigned long long* mb0, LAS unsigned* hist, LAS unsigned* kbuf, int ntl, int lane) {
    unsigned vm = ntl >= 32 ? 0xffffffffu : ((1u << ntl) - 1u);
    asm volatile("" : "+v"(vm));
#pragma unroll 1
    for (int rr = 0; rr < 8; ++rr) {
        const GAS float* srow = sr0 + (size_t)rr * SEQ;
        float fv[NJ];
#pragma unroll
        for (int j = 0; j < NJ; ++j) fv[j] = srow[64 * j];
        { unsigned z = 0u; asm volatile("" : "+v"(z));
          *(LAS u32x4*)(hist + 4 * lane) = (u32x4){z, z, z, z}; if (lane < 2) hist[256 + lane] = z; }
        __builtin_amdgcn_wave_barrier();
        unsigned key[NJ];
#pragma unroll
        for (int j = 0; j < NJ; ++j) {
            const float f = fv[j]; const bool ok = (vm >> j) & 1u;
            key[j] = ok ? skey_of(f) : 0u;
            const int bk = min(max((int)floorf(f + f) + 128, 0), 255);
            __hip_atomic_fetch_add(hist + (ok ? bk : 256), 1u, __ATOMIC_RELAXED, __HIP_MEMORY_SCOPE_WORKGROUP);
        }
        __builtin_amdgcn_wave_barrier();
        asm volatile("s_waitcnt lgkmcnt(0)" ::: "memory");
        unsigned B, rem, C;
        {
            const u32x4 hv = *(const LAS u32x4*)(hist + 4 * lane);
            const unsigned s4 = hv.x + hv.y + hv.z + hv.w;
            unsigned S = s4;
#pragma unroll
            for (int off = 1; off < 64; off <<= 1) { const unsigned n = __shfl_down(S, off); if (lane + off < 64) S += n; }
            const unsigned excl = S - s4;
            const bool mine = (excl < 256u) && (256u <= S);
            unsigned dl, above, cnt, c = excl;
            if (c + hv.w >= 256u) { dl = 3; above = c; cnt = hv.w; } else { c += hv.w; if (c + hv.z >= 256u) { dl = 2; above = c; cnt = hv.z; } else { c += hv.z; if (c + hv.y >= 256u) { dl = 1; above = c; cnt = hv.y; } else { c += hv.y; dl = 0; above = c; cnt = hv.x; } } }
            const unsigned long long bm = __ballot(mine);
            const int src = bm ? (int)__builtin_ctzll(bm) : 0;
            B = (unsigned)__builtin_amdgcn_readlane((int)(4 * lane + dl), src);
            rem = 256u - (unsigned)__builtin_amdgcn_readlane((int)above, src);
            C = (unsigned)__builtin_amdgcn_readlane((int)cnt, src);
        }
        const unsigned klo = (B == 0u) ? 1u : skey_of((float)((int)B - 128) * 0.5f);
        const unsigned khi = (B == 255u) ? 0xffffffffu : skey_of((float)((int)B - 127) * 0.5f);
        const unsigned range = khi - klo;
        unsigned tau = 0u, remf = 0u, cnteq = 0u; bool generic = C > 64u;
        if (!generic) {
#pragma unroll
            for (int j = 0; j < NJ; ++j) {
                if ((key[j] - klo) < range) { const unsigned slot = __hip_atomic_fetch_add(hist + 257, 1u, __ATOMIC_RELAXED, __HIP_MEMORY_SCOPE_WORKGROUP); hist[258 + (slot & 63u)] = key[j]; }
            }
            __builtin_amdgcn_wave_barrier();
            asm volatile("s_waitcnt lgkmcnt(0)" ::: "memory");
            const bool have = (unsigned)lane < C;
            const unsigned mykey = have ? hist[258 + lane] : 0u;
            unsigned cgt = 0u;
            for (unsigned i = 0; i < C; ++i) { const unsigned o = (unsigned)__builtin_amdgcn_readlane((int)mykey, (int)i); cgt += (o > mykey) ? 1u : 0u; }
            unsigned t = (have && cgt < rem) ? mykey : 0xffffffffu;
#pragma unroll
            for (int o = 1; o < 64; o <<= 1) t = min(t, (unsigned)__shfl_xor((int)t, o));
            tau = t;
            const unsigned long long eqm = __ballot(have && mykey == tau);
            cnteq = (unsigned)__popcll(eqm);
            remf = rem - (unsigned)__builtin_amdgcn_readlane((int)cgt, eqm ? (int)__builtin_ctzll(eqm) : 0);
            generic = cnteq > remf;
        }
        unsigned mlo = 0u, mhi = 0u;
        if (!generic) {
#define WL1(J) if constexpr (J < NJ) { const unsigned long long w_ = __ballot(key[J] >= tau); const unsigned wl_ = (unsigned)w_, wh_ = (unsigned)(w_ >> 32); \
                asm volatile("s_nop 3\n\tv_writelane_b32 %0, %2, " #J "\n\tv_writelane_b32 %1, %3, " #J : "+v"(mlo), "+v"(mhi) : "s"(wl_), "s"(wh_)); }
            WL1(0) WL1(1) WL1(2) WL1(3) WL1(4) WL1(5) WL1(6) WL1(7) WL1(8) WL1(9) WL1(10) WL1(11) WL1(12) WL1(13) WL1(14) WL1(15)
            WL1(16) WL1(17) WL1(18) WL1(19) WL1(20) WL1(21) WL1(22) WL1(23) WL1(24) WL1(25) WL1(26) WL1(27) WL1(28) WL1(29) WL1(30) WL1(31)
#undef WL1
        } else {
#pragma unroll
            for (int j = 0; j < NJ; ++j) kbuf[64 * j + lane] = key[j];
            __builtin_amdgcn_wave_barrier();
            asm volatile("s_waitcnt lgkmcnt(0)" ::: "memory");
            unsigned pre = 0u;
            for (int bit = 31; bit >= 0; --bit) {
                const unsigned trial = pre | (1u << bit); unsigned cnt = 0u;
                for (int j = 0; j < NJ; ++j) cnt += (unsigned)__popcll(__ballot(kbuf[64 * j + lane] >= trial));
                if (cnt >= 256u) pre = trial;
            }
            unsigned cg = 0u;
            for (int j = 0; j < NJ; ++j) cg += (unsigned)__popcll(__ballot(kbuf[64 * j + lane] > pre));
            const unsigned take = 256u - cg; unsigned running = 0u;
            const unsigned long long lt_mask = (1ull << lane) - 1ull;
            for (int j = 0; j < NJ; ++j) {
                const unsigned k = kbuf[64 * j + lane];
                const bool eq = k == pre; const unsigned long long eqb = __ballot(eq);
                const unsigned before = running + (unsigned)__popcll(eqb & lt_mask);
                const unsigned long long w = __ballot(k > pre || (eq && before < take));
                running += (unsigned)__popcll(eqb);
                if (lane == j) { mlo = (unsigned)w; mhi = (unsigned)(w >> 32); }
            }
            __builtin_amdgcn_wave_barrier();
        }
        if (lane < 32) mb0[rr * 32 + lane] = ((unsigned long long)mhi << 32) | mlo;
    }
}

__device__ __forceinline__ unsigned sortable(float f) { unsigned u = __float_as_uint(f); if (u == 0x80000000u) u = 0u; return (u & 0x80000000u) ? ~u : (u | 0x80000000u); }
__device__ __forceinline__ void select_unit(LAS unsigned char* lds, const GAS bf16_t* __restrict__ HA, const GAS float* __restrict__ IW, int b, int qc, GAS float* __restrict__ scr, GAS unsigned long long* __restrict__ MB) {
    const int tid = opaque_tid(), lane = tid & 63, r32 = lane & 31, hi = lane >> 5; const int wid = __builtin_amdgcn_readfirstlane(tid >> 6);
    const size_t rowbase = (size_t)b * SEQ; const int ntl = qc + 1;
    if (ntl > 4) {
        const int c16 = lane & 15, lg = lane >> 4;
        const int ql = 16 * (wid & 3) + c16; const size_t qrow = rowbase + qc * 64 + ql;
        bf16x8 iqf[8][2]; float iwv[8];
        { const GAS bf16_t* qp = HA + qrow * LDH + 2560 + lg * 8;
#pragma unroll
          for (int hh = 0; hh < 8; ++hh) { iqf[hh][0] = *(const GAS bf16x8*)(qp + hh * 64); iqf[hh][1] = *(const GAS bf16x8*)(qp + hh * 64 + 32); }
          const f32x4 w0 = *(const GAS f32x4*)(IW + qrow * 8), w1 = *(const GAS f32x4*)(IW + qrow * 8 + 4);
          iwv[0] = w0[0]; iwv[1] = w0[1]; iwv[2] = w0[2]; iwv[3] = w0[3]; iwv[4] = w1[0]; iwv[5] = w1[1]; iwv[6] = w1[2]; iwv[7] = w1[3]; }
        const int nkb = 4 * ntl, nchunk = (ntl + 3) >> 2;
        const int srw = tid >> 3, sch = tid & 7;
        const GAS bf16_t* kgp = HA + (rowbase + srw) * LDH + 3072 + sch * 8;
        u32x4 kr[4];
#pragma unroll
        for (int i = 0; i < 4; ++i) if (i < ntl) kr[i] = *(const GAS u32x4*)(kgp + (size_t)(i * 64) * LDH);
#pragma unroll
        for (int i = 0; i < 4; ++i) if (i < ntl) *(LAS u32x4*)((LAS bf16_t*)lds + (i * 64 + srw) * 72 + sch * 8) = kr[i];
        __syncthreads();
        for (int c = 0; c < nchunk; ++c) {
            const int cur = c & 1; const bool more = c + 1 < nchunk;
            if (more) {
#pragma unroll
                for (int i = 0; i < 4; ++i) { const int tl = (c + 1) * 4 + i; if (tl < ntl) kr[i] = *(const GAS u32x4*)(kgp + (size_t)(tl * 64) * LDH); }
            }
            const LAS bf16_t* Kc = (const LAS bf16_t*)(lds + cur * 36864);
#pragma unroll 2
            for (int i = 0; i < 8; ++i) {
                const int kbl = (wid >> 2) + 2 * i, kb = c * 16 + kbl;
                if (kb < nkb) {
                    const LAS bf16_t* kp = Kc + (kbl * 16 + c16) * 72 + lg * 8;
                    const bf16x8 k0 = *(const LAS bf16x8*)kp, k1 = *(const LAS bf16x8*)(kp + 32);
                    f32x4 sc = (f32x4){0.f, 0.f, 0.f, 0.f};
#pragma unroll
                    for (int hh = 0; hh < 8; ++hh) {
                        f32x4 acc = __builtin_amdgcn_mfma_f32_16x16x32_bf16(k0, iqf[hh][0], (f32x4){0.f, 0.f, 0.f, 0.f}, 0, 0, 0);
                        acc = __builtin_amdgcn_mfma_f32_16x16x32_bf16(k1, iqf[hh][1], acc, 0, 0, 0);
#pragma unroll
                        for (int r = 0; r < 4; ++r) sc[r] += iwv[hh] * fmaxf(acc[r], 0.f);
                    }
                    *(GAS f32x4*)(scr + (size_t)ql * SEQ + kb * 16 + 4 * lg) = sc;
                }
            }
            if (more) {
#pragma unroll
                for (int i = 0; i < 4; ++i) { const int tl = (c + 1) * 4 + i; if (tl < ntl) *(LAS u32x4*)((LAS bf16_t*)(lds + (cur ^ 1) * 36864) + (i * 64 + srw) * 72 + sch * 8) = kr[i]; }
            }
            __syncthreads();
        }
    }
    asm volatile("s_waitcnt vmcnt(0)" ::: "memory");
    __syncthreads();
    l1_inv();
    GAS unsigned long long* mb0 = MB + (rowbase + qc * 64 + wid * 8) * 32;
    if (ntl <= 4) {
        for (int rr = 0; rr < 8; ++rr) if (lane < 32) mb0[rr * 32 + lane] = (lane < ntl) ? ~0ull : 0ull;
        return;
    }
    LAS unsigned* hist = (LAS unsigned*)(lds + 73728) + wid * 384;
    LAS unsigned* kbuf = (LAS unsigned*)lds + wid * 2048;
    const GAS float* sr0 = scr + (size_t)(wid * 8) * SEQ + lane;
    switch ((ntl + 7) >> 3) {
        case 1: select_rows<8>(sr0, mb0, hist, kbuf, ntl, lane); break;
        case 2: select_rows<16>(sr0, mb0, hist, kbuf, ntl, lane); break;
        case 3: select_rows<24>(sr0, mb0, hist, kbuf, ntl, lane); break;
        default: select_rows<32>(sr0, mb0, hist, kbuf, ntl, lane); break;
    }
}

__device__ __forceinline__ void ln_phase(const GAS bf16_t* Y, GAS bf16_t* XB, GAS float* OUT, const GAS float* g, const GAS float* bta, bool write_bf) {
    const int tid = opaque_tid(), lane = tid & 63, wid = tid >> 6;
    const int gw = blockIdx.x * 8 + wid, NGW = gridDim.x * 8;
    f32x4 gv[4], bv[4];
#pragma unroll
    for (int j = 0; j < 4; ++j) { gv[j] = *(const GAS f32x4*)(g + 4 * lane + 256 * j); bv[j] = *(const GAS f32x4*)(bta + 4 * lane + 256 * j); }
    constexpr int RB = 4;
    for (int row0 = gw; row0 < T_TOK; row0 += RB * NGW) {
        u32x2 w[RB][4];
#pragma unroll
        for (int r = 0; r < RB; ++r) { const int row = min(row0 + r * NGW, T_TOK - 1); const size_t ro = (size_t)row * DM + 4 * lane;
#pragma unroll
            for (int j = 0; j < 4; ++j) w[r][j] = __builtin_nontemporal_load((const GAS u32x2*)(Y + ro + 256 * j)); }
#pragma unroll
        for (int r = 0; r < RB; ++r) {
            const int row = row0 + r * NGW;
            if (row < T_TOK) {
                const size_t ro = (size_t)row * DM + 4 * lane;
                f32x4 v[4]; float s = 0.f;
#pragma unroll
                for (int j = 0; j < 4; ++j) { v[j] = (f32x4){bflo(w[r][j].x), bfhi(w[r][j].x), bflo(w[r][j].y), bfhi(w[r][j].y)}; s += (v[j][0] + v[j][1]) + (v[j][2] + v[j][3]); }
#pragma unroll
                for (int o = 1; o < 64; o <<= 1) s += __shfl_xor(s, o);
                const float mean = s * (1.f / DM); float s2 = 0.f;
#pragma unroll
                for (int j = 0; j < 4; ++j) { v[j] = v[j] - mean; s2 += (v[j][0] * v[j][0] + v[j][1] * v[j][1]) + (v[j][2] * v[j][2] + v[j][3] * v[j][3]); }
#pragma unroll
                for (int o = 1; o < 64; o <<= 1) s2 += __shfl_xor(s2, o);
                const float rstd = 1.f / sqrtf(s2 * (1.f / DM) + LN_EPS);
#pragma unroll
                for (int j = 0; j < 4; ++j) { const f32x4 y = v[j] * rstd * gv[j] + bv[j];
                    if (write_bf) { u32x2 o2; o2.x = cvtpk(y[0], y[1]); o2.y = cvtpk(y[2], y[3]); *(GAS u32x2*)(XB + ro + 256 * j) = o2; }
                    else __builtin_nontemporal_store(y, (GAS f32x4*)(OUT + ro + 256 * j)); }
            }
        }
    }
}

#define XB_TMO      128
#define XB_XCNT(j)  (256  + 64 * (j))
#define XB_XSUB(j)  (1280 + 64 * (j))
#define XB_XGEN(j)  (2304 + 64 * (j))
#define XB_TOP      3328
#define XB_TOPGEN   3392
#define XCD_BAR_WORDS 3456
#define XB_SPIN_CAP (1u << 18)

__device__ __forceinline__ unsigned xb_ld(unsigned* p)              { return __hip_atomic_load(p, __ATOMIC_RELAXED, __HIP_MEMORY_SCOPE_AGENT); }
__device__ __forceinline__ unsigned xb_add(unsigned* p, unsigned v) { return __hip_atomic_fetch_add(p, v, __ATOMIC_RELAXED, __HIP_MEMORY_SCOPE_AGENT); }
__device__ __forceinline__ unsigned xb_xcc_id() { return (unsigned)__builtin_amdgcn_s_getreg((3 << 11) | 20) & 0xFu; }
#define XB_SPIN(cond, bar) do { unsigned _sp = 0; while (cond) { __builtin_amdgcn_s_sleep(1); \
    if ((++_sp & 255u) == 0u) { if (xb_ld(&(bar)[XB_TMO])) break; if (_sp > XB_SPIN_CAP) { atomicAdd(&(bar)[XB_TMO], 1u); break; } } } } while (0)

struct XcdBarrier {
    unsigned* bar; unsigned x;
    volatile LAS unsigned* st;
};

__device__ __forceinline__ XcdBarrier xcd_barrier_post(unsigned* bar, volatile LAS unsigned* st) {
    XcdBarrier b; b.bar = bar; b.x = xb_xcc_id(); b.st = st;
    if (threadIdx.x == 0) (void)xb_add(&bar[XB_XCNT(b.x)], 1u);
    return b;
}
__device__ __forceinline__ void xcd_barrier_complete(unsigned* bar, unsigned x, unsigned& nloc, unsigned& nx) {
    const unsigned G = gridDim.x * gridDim.y * gridDim.z;
    unsigned sum, cnt, mine, sp = 0u;
    for (;;) {
        sum = 0u; cnt = 0u; mine = 0u;
#pragma unroll
        for (unsigned j = 0; j < 16; ++j) { const unsigned c = xb_ld(&bar[XB_XCNT(j)]); sum += c; cnt += (c > 0u) ? 1u : 0u; mine = (j == x) ? c : mine; }
        if (sum == G) break;
        __builtin_amdgcn_s_sleep(1);
        if ((++sp & 255u) == 0u) { if (xb_ld(&bar[XB_TMO])) break; if (sp > XB_SPIN_CAP) { atomicAdd(&bar[XB_TMO], 1u); break; } }
    }
    nloc = mine > 0u ? mine : 1u; nx = cnt > 0u ? cnt : 1u;
}

__device__ __forceinline__ void xcd_barrier(const XcdBarrier& b) {
    asm volatile("s_waitcnt vmcnt(0)" ::: "memory");
    __syncthreads();
    if (threadIdx.x == 0) {
        unsigned* bar = b.bar;
        __builtin_amdgcn_s_waitcnt(0);
        unsigned nloc = b.st[0], nx = b.st[1];
        if (nloc == 0u) { xcd_barrier_complete(bar, b.x, nloc, nx); b.st[0] = nloc; b.st[1] = nx; }
        const unsigned old = xb_add(&bar[XB_XSUB(b.x)], 1u);
        const unsigned gen = old / nloc;
        if (old + 1u == (gen + 1u) * nloc) {
            __builtin_amdgcn_fence(__ATOMIC_RELEASE, "agent");
            asm volatile("s_waitcnt vmcnt(0)" ::: "memory");
            const unsigned og = xb_add(&bar[XB_TOP], 1u);
            const unsigned tg = og / nx;
            if (og + 1u == (tg + 1u) * nx) xb_add(&bar[XB_TOPGEN], 1u);
            else XB_SPIN(xb_ld(&bar[XB_TOPGEN]) == tg, bar);
            __builtin_amdgcn_fence(__ATOMIC_ACQUIRE, "agent");
            xb_add(&bar[XB_XGEN(b.x)], 1u);
            asm volatile("s_waitcnt vmcnt(0)" ::: "memory");
        } else {
            XB_SPIN(xb_ld(&bar[XB_XGEN(b.x)]) == gen, bar);
            __builtin_amdgcn_fence(__ATOMIC_ACQUIRE, "agent");
            asm volatile("s_waitcnt vmcnt(0)" ::: "memory");
        }
    }
    __syncthreads();
}


__global__ void __launch_bounds__(512, 2) mega_fwd(Args a) {
    extern __shared__ __attribute__((aligned(16))) unsigned char lds_raw[];
    LAS unsigned char* lds = (LAS unsigned char*)lds_raw;
    LAS unsigned* slot = (LAS unsigned*)(lds + LDS_SLOT);
    cg::grid_group grid = cg::this_grid();
    volatile LAS unsigned* bst = (volatile LAS unsigned*)(lds + LDS_SLOT + 16);
    if (threadIdx.x < 2) bst[threadIdx.x] = 0u;
    if (blockIdx.x == 0) { GAS u32x4* cz = (GAS u32x4*)(a.ws + WS_CTL); for (int i = threadIdx.x; i < 2048; i += 512) cz[i] = (u32x4){0u, 0u, 0u, 0u}; }
    __syncthreads();
#define GSYNC() do { XcdBarrier xb_; xb_.bar = (unsigned*)(KA->ws + WS_CTL) + 2048; xb_.x = xb_xcc_id(); xb_.st = (volatile LAS unsigned*)(lds + LDS_SLOT + 16); xcd_barrier(xb_); } while (0)
    const volatile __attribute__((address_space(4))) Args* KA = (const volatile __attribute__((address_space(4))) Args*)__builtin_amdgcn_kernarg_segment_ptr();
#define PH unsigned char* ws = KA->ws; int L = Lc; asm volatile("" : "+s"(ws), "+s"(L)); const unsigned char* wl = ws + WS_W + (size_t)L * W_LAYER; (void)wl
    prologue(lds, a);
    grid.sync();
    (void)xcd_barrier_post((unsigned*)(KA->ws + WS_CTL) + 2048, bst);
    for (int Lc = 0; Lc < 2; ++Lc) {
        {
            PH;
            run_gemm(lds, (const bf16_t*)(ws + WS_XB), (const bf16_t*)(wl + WO_IN), T_TOK, NIN, DM, FIn{(GAS bf16_t*)(ws + WS_HA), (GAS float*)(ws + WS_FL), (GAS float*)(ws + WS_IW), (const GAS float*)(ws + WS_TRIG)});
        }
        GSYNC();
        {
            PH;
            unsigned* ctr = (unsigned*)(ws + WS_CTL) + 64 * (2 * L);
            const GAS float* bfg = (const GAS float*)KA->in[3] + L * 6;
            const GAS bf16_t* HA = (const GAS bf16_t*)(ws + WS_HA); const GAS float* FL = (const GAS float*)(ws + WS_FL); const GAS float* IW = (const GAS float*)(ws + WS_IW);
            GAS bf16_t* OC = (GAS bf16_t*)(ws + WS_OC); GAS unsigned long long* MB = (GAS unsigned long long*)(ws + WS_MB);
            GAS float* scr = (GAS float*)(ws + WS_SCR) + (size_t)blockIdx.x * 64 * SEQ;
            for (;;) {
                const int u = next_unit(ctr, slot); if (u >= 3840) break;
                const int lev = 7 - u / 480, rem = u % 480;
                if (rem < 192) { const int b = rem / 6, h = rem % 6; attn_unit<0>(lds, HA, b, lev, h * 64, 384 + h * 64, 768 + h * 64, OC, h * 64, FL + h, bfg[h], MB); }
                else if (rem < 352) { const int e = rem - 192, b = e / 5, h = e % 5; attn_unit<1>(lds, HA, b, lev, 1152 + h * 64, 1472 + h * 64, 1792 + h * 64, OC + OC_STRIDE, h * 64, FL, 0.f, MB); }
                else { const int s = rem - 352, qc = 4 * lev + 3 - (s >> 5), b = s & 31; select_unit(lds, HA, IW, b, qc, scr, MB); }
            }
        }
        GSYNC();
        {
            PH;
            unsigned* ctr = (unsigned*)(ws + WS_CTL) + 64 * (2 * L + 1);
            const GAS bf16_t* HA = (const GAS bf16_t*)(ws + WS_HA); GAS bf16_t* OC = (GAS bf16_t*)(ws + WS_OC); const GAS unsigned long long* MB = (const GAS unsigned long long*)(ws + WS_MB);
            for (;;) {
                const int u = next_unit(ctr, slot); if (u >= 1280) break;
                const int qb = 7 - u / 160, e = u % 160, b = e / 5, h = e % 5;
                attn_unit<2>(lds, HA, b, qb, 2112 + h * 64, 2432, 2496, OC + 2 * OC_STRIDE, h * 64, (const GAS float*)nullptr, 0.f, MB);
            }
        }
        GSYNC();
        for (int ui = 0; ui < 64; ++ui) {
            pg8::Unit u;
            { pg8::StaticOrder S; S.init(T_TOK, DM, (int)gridDim.x, (int)blockIdx.x); if (!S.next(ui, u)) break; }
            { PH;
              GAS unsigned char* Gt = (GAS unsigned char*)(ws + WS_MF + (size_t)blockIdx.x * 393216);
              run_gemm_tri(lds, (const bf16_t*)(ws + WS_XB), (const bf16_t*)(wl + WO_G), T_TOK, 3 * DM, DM, TriUnit{u.pm, u.pn, 0}, FGateT3{Gt, 256 * u.pm, 256 * u.pn}); }
            { PH;
              GAS unsigned char* Gt = (GAS unsigned char*)(ws + WS_MF + (size_t)blockIdx.x * 393216);
              l1_inv();
              run_gemm_chain(lds, (const bf16_t*)(ws + WS_OC), (const bf16_t*)(wl + WO_UP), 3 * T_TOK, 3 * DM, OCW, TriUnit{u.pm, u.pn, 256},
                             EpiUpChain{Gt, (GAS bf16_t*)(ws + WS_G), 256 * u.pm, 256 * u.pn}); }
        }
        GSYNC();
        {
            PH;
            run_gemm(lds, (const bf16_t*)(ws + WS_G), (const bf16_t*)(wl + WO_OUT), T_TOK, DM, DM, FOut{L == 0 ? (const GAS float*)KA->in[0] : (const GAS float*)nullptr, (const GAS bf16_t*)(ws + WS_XB), (GAS bf16_t*)(ws + WS_PG)});
        }
        GSYNC();
        {
            PH;
            ln_phase((const GAS bf16_t*)(ws + WS_PG), (GAS bf16_t*)(ws + WS_XB), (GAS float*)KA->out, (const GAS float*)KA->in[8] + L * DM, (const GAS float*)KA->in[9] + L * DM, true);
            {
                const GAS f32x4* ps = (const GAS f32x4*)KA->in[1] + (size_t)L * T_TOK * 64; GAS bf16_t* hf = (GAS bf16_t*)(ws + WS_HFF);
                const size_t NT = (size_t)gridDim.x * 512, np = (size_t)T_TOK * 32; size_t i = (size_t)blockIdx.x * 512 + opaque_tid();
                for (; i + 3 * NT < np; i += 4 * NT) {
                    f32x4 v[8];
#pragma unroll
                    for (int k = 0; k < 4; ++k) { v[2 * k] = ps[2 * (i + k * NT)]; v[2 * k + 1] = ps[2 * (i + k * NT) + 1]; }
#pragma unroll
                    for (int k = 0; k < 4; ++k) { const size_t ii = i + k * NT; *(GAS u32x4*)(hf + (ii >> 5) * HFP + (ii & 31) * 8) = pack8(v[2 * k], v[2 * k + 1]); }
                }
                for (; i < np; i += NT) *(GAS u32x4*)(hf + (i >> 5) * HFP + (i & 31) * 8) = pack8(ps[2 * i], ps[2 * i + 1]);
            }
        }
        GSYNC();
        {
            PH;
            run_gemm(lds, (const bf16_t*)(ws + WS_XB), (const bf16_t*)(wl + WO_FF1), T_TOK, NFF1, DM, FFf1{(GAS bf16_t*)(ws + WS_HFF), (GAS bf16_t*)(ws + WS_PG)});
        }
        GSYNC();
        {
            PH;
            run_gemm_ff2(lds, (const bf16_t*)(ws + WS_HFF), (const bf16_t*)(wl + WO_FF2), T_TOK, DM, HFP, EpiFf2{(const GAS bf16_t*)(ws + WS_XB), (GAS bf16_t*)(ws + WS_PG)});
        }
        GSYNC();
        {
            PH;
            ln_phase((const GAS bf16_t*)(ws + WS_PG), (GAS bf16_t*)(ws + WS_XB), (GAS float*)KA->out, (const GAS float*)KA->in[14] + L * DM, (const GAS float*)KA->in[15] + L * DM, L == 0);
        }
        if (Lc == 0) GSYNC();
    }
#undef PH
}

extern "C" void kernel_launch(void* const* d_in, const int* in_sizes, int n_in, void* d_out, int out_size, void* d_ws, size_t ws_size, hipStream_t stream) {
    static int grid_blocks = 0;
    if (grid_blocks == 0) {
        if (n_in != 16 || out_size != T_TOK * DM || ws_size < WS_END) { fprintf(stderr, "kernel_launch: unexpected problem (n_in %d out %d ws %zu, need %zu)\n", n_in, out_size, ws_size, (size_t)WS_END); grid_blocks = -1; return; }
        int dev = 0, cus = 0, per_cu = 0;
        hipGetDevice(&dev);
        hipDeviceGetAttribute(&cus, hipDeviceAttributeMultiprocessorCount, dev);
        hipFuncSetAttribute((const void*)mega_fwd, hipFuncAttributeMaxDynamicSharedMemorySize, LDS_BYTES);
        hipOccupancyMaxActiveBlocksPerMultiprocessor(&per_cu, (const void*)mega_fwd, 512, LDS_BYTES);
        if (per_cu < 1) { fprintf(stderr, "kernel_launch: occupancy query returned %d\n", per_cu); per_cu = 1; }
        grid_blocks = cus * per_cu;
        (void)hipGetLastError();
    }
    if (grid_blocks < 0) return;
    Args a{};
    for (int i = 0; i < 16; ++i) a.in[i] = (const float*)d_in[i];
    a.out = (float*)d_out; a.ws = (unsigned char*)d_ws;
    void* args[] = {&a};
    hipError_t e = hipLaunchCooperativeKernel((const void*)mega_fwd, dim3(grid_blocks), dim3(512), args, LDS_BYTES, stream);
    if (e != hipSuccess) fprintf(stderr, "cooperative launch failed: %s (grid %d)\n", hipGetErrorString(e), grid_blocks);
}
```
